# Optimizing an MI355X kernel written in HIP

```python
import math
import jax, jax.numpy as jnp
from jax import lax
import numpy as np

D_MODEL = 2048
BATCH = 1
SEQ = 8192
DEPTH = 2

GRID_W = 64
CTX_LEN = 256
N_BRANCH = 4
BRANCH_W = D_MODEL // 4
CHUNK = 128
A_GROUPS = 4
CONV_W = 31
F_GROUPS = 4
QK_NOPE = 64
QK_ROPE = 32
V_HEAD = 64
MLA_HEADS = BRANCH_W // V_HEAD
Q_LORA = D_MODEL // 4
KV_LORA = D_MODEL // 8
ROPE_THETA = 10000.0
Q_BLOCK = 128
MLA_SCALE = (QK_NOPE + QK_ROPE) ** -0.5
N_GROUPS = 4
EXP_PER_GROUP = 8
N_EXPERTS = N_GROUPS * EXP_PER_GROUP
TOP_K = 2
D_EXPERT = D_MODEL // 2
MOE_BLOCK = 128
COL_A = 0
COL_B = COL_A + 2 * BRANCH_W
COL_C = COL_B + 2 * BRANCH_W
COL_D = COL_C + BRANCH_W
COL_KV = COL_D + Q_LORA
COL_KR = COL_KV + KV_LORA
COL_G = COL_KR + QK_ROPE
D_IN = COL_G + N_BRANCH * D_MODEL
ALPHA = (2 * DEPTH) ** 0.25
BETA = (8 * DEPTH) ** -0.25
LN_EPS = 1e-6

kernel_name = "hybrid_gated_mixers_mla_hmoe_dit"


def _ln0(x):
    xf = x.astype(jnp.float32)
    mu = xf.mean(-1, keepdims=True)
    var = jnp.square(xf - mu).mean(-1, keepdims=True)
    return ((xf - mu) * lax.rsqrt(var + LN_EPS)).astype(x.dtype)


def _ln(x, g, b):
    xf = x.astype(jnp.float32)
    mu = xf.mean(-1, keepdims=True)
    var = jnp.square(xf - mu).mean(-1, keepdims=True)
    y = (xf - mu) * lax.rsqrt(var + LN_EPS)
    return (y * g.astype(jnp.float32) + b.astype(jnp.float32)).astype(x.dtype)


def _rms(x, g):
    xf = x.astype(jnp.float32)
    y = xf * lax.rsqrt(jnp.mean(xf * xf, -1, keepdims=True) + LN_EPS)
    return (y * g.astype(jnp.float32)).astype(x.dtype)


def _modulate(x, shift, scale):
    return _ln0(x) * (1 + scale) + shift


def _axial_rope_tables(s_len, dtype):
    rows = s_len // GRID_W
    row = jnp.repeat(jnp.arange(rows, dtype=jnp.float32), GRID_W)
    col = jnp.tile(jnp.arange(GRID_W, dtype=jnp.float32), rows)
    half = QK_ROPE // 2
    inv = ROPE_THETA ** (-jnp.arange(0, half, 2, dtype=jnp.float32) / half)
    ar = row[:, None] * inv
    ac = col[:, None] * inv
    ang = jnp.concatenate([ar, ar, ac, ac], -1)
    return jnp.cos(ang).astype(dtype), jnp.sin(ang).astype(dtype)


def _rope(x, cos, sin):
    x1, x2, x3, x4 = jnp.split(x, 4, -1)
    rot = jnp.concatenate([-x2, x1, -x4, x3], -1)
    return x * cos + rot * sin


def _chunk_spatial_gate(uv, p):
    b_, n_tok, _ = uv.shape
    uv = jax.nn.gelu(uv)
    u, v = jnp.split(uv, 2, -1)
    v = _ln(v, p["a_ln_g"], p["a_ln_b"])
    v = v.reshape(b_, n_tok // CHUNK, CHUNK, A_GROUPS, BRANCH_W // A_GROUPS)
    mixed = jnp.einsum("gpq,bnqgc->bnpgc", p["a_w_s"], v) + p["a_b_s"].T[None, None, :, :, None]
    return u * mixed.reshape(b_, n_tok, BRANCH_W)


def _conformer_conv(ab, p):
    a, g = jnp.split(ab, 2, -1)
    y = a * jax.nn.sigmoid(g)
    y = lax.conv_general_dilated(y, p["b_w_dw"][:, None, :], (1,), [(CONV_W // 2, CONV_W // 2)],
                                 dimension_numbers=("NWC", "WIO", "NWC"), feature_group_count=BRANCH_W)
    y = y + p["b_b_dw"]
    return jax.nn.silu(_ln(y, p["b_ln_g"], p["b_ln_b"]))


def _fourier_mix(z):
    b_, n_tok, ch = z.shape
    zf = z.astype(jnp.float32).reshape(b_, n_tok, F_GROUPS, ch // F_GROUPS)
    y = jnp.fft.fft2(zf, axes=(1, 3), norm="ortho").real
    return y.reshape(b_, n_tok, ch).astype(z.dtype)


def _local_mixers(z, p):
    return (_chunk_spatial_gate(z[..., COL_A:COL_B], p),
            _conformer_conv(z[..., COL_B:COL_C], p),
            _fourier_mix(z[..., COL_C:COL_D]))


def _mla_queries(cq, p):
    b_, n_tok, _ = cq.shape
    q = (_rms(cq, p["d_q_g"]) @ p["d_w_uq"]).reshape(b_, n_tok, MLA_HEADS, QK_NOPE + QK_ROPE)
    return q[..., :QK_NOPE], q[..., QK_NOPE:]


def _mla_kv(ckv, p):
    b_, n_tok, _ = ckv.shape
    ckv = _rms(ckv, p["d_kv_g"])
    kn = (ckv @ p["d_w_uk"]).reshape(b_, n_tok, MLA_HEADS, QK_NOPE)
    v = (ckv @ p["d_w_uv"]).reshape(b_, n_tok, MLA_HEADS, V_HEAD)
    return kn, v


def _attend(qn, qr, kn, kr, v):
    s = jnp.einsum("bqhd,bkhd->bhqk", qn, kn) + jnp.einsum("bqhr,bkr->bhqk", qr, kr)
    pr = jax.nn.softmax(s.astype(jnp.float32) * MLA_SCALE, axis=-1).astype(v.dtype)
    o = jnp.einsum("bhqk,bkhd->bqhd", pr, v)
    return o.reshape(o.shape[0], o.shape[1], MLA_HEADS * V_HEAD)


def _attend_blocked(qn, qr, kn, kr, v):
    b_, n_tok = qn.shape[:2]
    nb = n_tok // Q_BLOCK

    def blk(t):
        return t.reshape(b_, nb, Q_BLOCK, *t.shape[2:]).swapaxes(0, 1)

    o = lax.map(lambda a: _attend(a[0], a[1], kn, kr, v), (blk(qn), blk(qr)))
    return o.swapaxes(0, 1).reshape(b_, n_tok, MLA_HEADS * V_HEAD)


def _merge(z, branches, p):
    b_, n_tok, _ = z.shape
    gates = jax.nn.sigmoid(z[..., COL_G:].reshape(b_, n_tok, N_BRANCH, D_MODEL))
    y = 0
    for i, br in enumerate(branches):
        y = y + gates[:, :, i, :] * (br @ p["w_branch"][i])
    return y @ p["w_o"]


def _hier_moe(h, w_grp, b_grp, w_exp, b_exp, w1, w3, w2):
    n_t, d = h.shape
    g_logit = (h @ w_grp).astype(jnp.float32) + b_grp.astype(jnp.float32)
    g_idx = jnp.argmax(g_logit, -1).astype(jnp.int32)
    g_p = jnp.take_along_axis(jax.nn.softmax(g_logit, -1), g_idx[:, None], -1)
    e_logit = ((h @ w_exp).astype(jnp.float32) + b_exp.astype(jnp.float32)).reshape(n_t, N_GROUPS, EXP_PER_GROUP)
    e_logit = jnp.take_along_axis(e_logit, g_idx[:, None, None], 1)[:, 0]
    top_v, top_i = lax.top_k(e_logit, TOP_K)
    gate = (jax.nn.softmax(top_v, -1) * g_p).astype(h.dtype).reshape(-1)
    expert = (g_idx[:, None] * EXP_PER_GROUP + top_i.astype(jnp.int32)).reshape(-1)
    tok = jnp.repeat(jnp.arange(n_t, dtype=jnp.int32), TOP_K)
    n = n_t * TOP_K
    order = jnp.argsort(expert)
    se, stok, sgate = expert[order], tok[order], gate[order]
    counts = jax.ops.segment_sum(jnp.ones((n,), jnp.int32), expert, num_segments=N_EXPERTS)
    starts = jnp.cumsum(counts) - counts
    padded = (counts + MOE_BLOCK - 1) // MOE_BLOCK * MOE_BLOCK
    pends = jnp.cumsum(padded)
    pstarts = pends - padded
    dest = pstarts[se] + jnp.arange(n, dtype=jnp.int32) - starts[se]
    n_rows = -(-(n + N_EXPERTS * (MOE_BLOCK - 1)) // MOE_BLOCK) * MOE_BLOCK
    n_blk = n_rows // MOE_BLOCK
    row_tok = jnp.zeros((n_rows,), jnp.int32).at[dest].set(stok)
    row_gate = jnp.zeros((n_rows,), h.dtype).at[dest].set(sgate)
    blk_start = jnp.arange(n_blk, dtype=jnp.int32) * MOE_BLOCK
    blk_exp = jnp.minimum(jnp.sum(pends[None, :] <= blk_start[:, None], axis=1), N_EXPERTS - 1).astype(jnp.int32)

    def run(args):
        t, e = args
        xb = h[t]
        return (jax.nn.silu(xb @ w1[e]) * (xb @ w3[e])) @ w2[e]

    y = lax.map(run, (row_tok.reshape(n_blk, MOE_BLOCK), blk_exp)).reshape(n_rows, d)
    return jnp.zeros_like(h).at[row_tok].add(y * row_gate[:, None])


def setup_inputs(seed: int = 0) -> dict:
    key = jax.random.key(seed)
    ks = iter(jax.random.split(key, 48))
    L, D = DEPTH, D_MODEL

    def nrm(shape, s):
        return jax.random.normal(next(ks), shape, jnp.float32) * s

    return {
        "x": nrm((BATCH, SEQ, D), 1.0),
        "c": nrm((BATCH, D), 1.0),
        "ctx": nrm((BATCH, CTX_LEN, D), 1.0),
        "c_ctx": nrm((D,), 1.0),
        "w_ada": nrm((L, D, 6 * D), 0.5 * D ** -0.5),
        "b_ada": nrm((L, 6 * D), 0.01),
        "w_in": nrm((L, D, D_IN), D ** -0.5),
        "b_in": nrm((L, D_IN), 0.01),
        "a_ln_g": 1.0 + nrm((L, BRANCH_W), 0.05),
        "a_ln_b": nrm((L, BRANCH_W), 0.01),
        "a_w_s": nrm((L, A_GROUPS, CHUNK, CHUNK), CHUNK ** -0.5),
        "a_b_s": 1.0 + nrm((L, A_GROUPS, CHUNK), 0.05),
        "b_w_dw": nrm((L, CONV_W, BRANCH_W), CONV_W ** -0.5),
        "b_b_dw": nrm((L, BRANCH_W), 0.01),
        "b_ln_g": 1.0 + nrm((L, BRANCH_W), 0.05),
        "b_ln_b": nrm((L, BRANCH_W), 0.01),
        "d_q_g": 1.0 + nrm((L, Q_LORA), 0.05),
        "d_w_uq": nrm((L, Q_LORA, MLA_HEADS * (QK_NOPE + QK_ROPE)), Q_LORA ** -0.5),
        "d_kv_g": 1.0 + nrm((L, KV_LORA), 0.05),
        "d_w_uk": nrm((L, KV_LORA, MLA_HEADS * QK_NOPE), KV_LORA ** -0.5),
        "d_w_uv": nrm((L, KV_LORA, MLA_HEADS * V_HEAD), KV_LORA ** -0.5),
        "w_branch": nrm((L, N_BRANCH, BRANCH_W, D), BETA * BRANCH_W ** -0.5),
        "w_o": nrm((L, D, D), BETA * D ** -0.5),
        "ln1_g": 1.0 + nrm((L, D), 0.05),
        "ln1_b": nrm((L, D), 0.01),
        "r_w_grp": nrm((L, D, N_GROUPS), D ** -0.5),
        "r_b_grp": nrm((L, N_GROUPS), 0.01),
        "r_w_exp": nrm((L, D, N_EXPERTS), D ** -0.5),
        "r_b_exp": nrm((L, N_EXPERTS), 0.01),
        "e_w1": nrm((L, N_EXPERTS, D, D_EXPERT), D ** -0.5),
        "e_w3": nrm((L, N_EXPERTS, D, D_EXPERT), D ** -0.5),
        "e_w2": nrm((L, N_EXPERTS, D_EXPERT, D), BETA * D_EXPERT ** -0.5),
        "ln2_g": 1.0 + nrm((L, D), 0.05),
        "ln2_b": nrm((L, D), 0.01),
    }


def reference(x, c, ctx, c_ctx, w_ada, b_ada, w_in, b_in, a_ln_g, a_ln_b, a_w_s, a_b_s,
              b_w_dw, b_b_dw, b_ln_g, b_ln_b, d_q_g, d_w_uq, d_kv_g, d_w_uk, d_w_uv,
              w_branch, w_o, ln1_g, ln1_b, r_w_grp, r_b_grp, r_w_exp, r_b_exp,
              e_w1, e_w3, e_w2, ln2_g, ln2_b):
    b_, s_len, d = x.shape
    n_ctx = ctx.shape[1]
    cos, sin = _axial_rope_tables(s_len, x.dtype)
    s_lat = jax.nn.silu(c)
    s_ctx = jax.nn.silu(c_ctx)[None]
    xl, xc = x, ctx
    for l in range(DEPTH):
        last = l == DEPTH - 1
        p = {"a_ln_g": a_ln_g[l], "a_ln_b": a_ln_b[l], "a_w_s": a_w_s[l], "a_b_s": a_b_s[l],
             "b_w_dw": b_w_dw[l], "b_b_dw": b_b_dw[l], "b_ln_g": b_ln_g[l], "b_ln_b": b_ln_b[l],
             "d_q_g": d_q_g[l], "d_w_uq": d_w_uq[l], "d_kv_g": d_kv_g[l], "d_w_uk": d_w_uk[l],
             "d_w_uv": d_w_uv[l], "w_branch": w_branch[l], "w_o": w_o[l]}
        ml = jnp.split((s_lat @ w_ada[l] + b_ada[l])[:, None, :], 6, -1)
        mc = jnp.split((s_ctx @ w_ada[l] + b_ada[l])[:, None, :], 6, -1)

        hl = _modulate(xl, ml[0], ml[1])
        hc = _modulate(xc, mc[0], mc[1])
        zl = hl @ w_in[l] + b_in[l]
        if last:
            zc = hc @ w_in[l][:, COL_KV:COL_G] + b_in[l][COL_KV:COL_G]
            zc_kv = zc
        else:
            zc = hc @ w_in[l] + b_in[l]
            zc_kv = zc[..., COL_KV:COL_G]
        kn_c, v_c = _mla_kv(zc_kv[..., :KV_LORA], p)
        kr_c = zc_kv[..., KV_LORA:]
        qn_l, qr_l = _mla_queries(zl[..., COL_D:COL_KV], p)
        qr_l = _rope(qr_l, cos[:, None, :], sin[:, None, :])
        kn_l, v_l = _mla_kv(zl[..., COL_KV:COL_KR], p)
        kr_l = _rope(zl[..., COL_KR:COL_G], cos, sin)
        yd_l = _attend_blocked(qn_l, qr_l,
                               jnp.concatenate([kn_c, kn_l], 1),
                               jnp.concatenate([kr_c, kr_l], 1),
                               jnp.concatenate([v_c, v_l], 1))
        mix_l = _merge(zl, _local_mixers(zl, p) + (yd_l,), p)
        if not last:
            qn_c, qr_c = _mla_queries(zc[..., COL_D:COL_KV], p)
            yd_c = _attend(qn_c, qr_c, kn_c, kr_c, v_c)
            mix_c = _merge(zc, _local_mixers(zc, p) + (yd_c,), p)
            xc = _ln(ALPHA * xc + mc[2] * mix_c, ln1_g[l], ln1_b[l])
        xl = _ln(ALPHA * xl + ml[2] * mix_l, ln1_g[l], ln1_b[l])

        hl = _modulate(xl, ml[3], ml[4]).reshape(-1, d)
        if last:
            fl = _hier_moe(hl, r_w_grp[l], r_b_grp[l], r_w_exp[l], r_b_exp[l],
                           e_w1[l], e_w3[l], e_w2[l]).reshape(b_, s_len, d)
        else:
            hc = _modulate(xc, mc[3], mc[4]).reshape(-1, d)
            f = _hier_moe(jnp.concatenate([hc, hl], 0), r_w_grp[l], r_b_grp[l], r_w_exp[l], r_b_exp[l],
                          e_w1[l], e_w3[l], e_w2[l])
            fc = f[:b_ * n_ctx].reshape(b_, n_ctx, d)
            fl = f[b_ * n_ctx:].reshape(b_, s_len, d)
            xc = _ln(ALPHA * xc + mc[5] * fc, ln2_g[l], ln2_b[l])
        xl = _ln(ALPHA * xl + ml[5] * fl, ln2_g[l], ln2_b[l])
    return xl
```

```cpp
#include <hip/hip_runtime.h>
#include <cstdio>
#include <cstdint>

#define LAS __attribute__((address_space(3)))
#define GAS __attribute__((address_space(1)))
typedef unsigned short bf16_t;
typedef short bf16x8 __attribute__((ext_vector_type(8)));
typedef short s16x4 __attribute__((ext_vector_type(4)));
typedef float f32x2 __attribute__((ext_vector_type(2)));
typedef float f32x4 __attribute__((ext_vector_type(4)));
typedef float f32x16 __attribute__((ext_vector_type(16)));
typedef unsigned u32x4 __attribute__((ext_vector_type(4)));
typedef unsigned u32x2 __attribute__((ext_vector_type(2)));

#ifndef MK_LAUNCH_PER_PHASE
#define MK_LAUNCH_PER_PHASE 0
#endif

constexpr int D = 2048, SEQ = 8192, CTX = 256, NROW = SEQ + CTX;
constexpr int DIN = 11552, NWIN = 46 * 256;
constexpr int NEXP = 32, DEXP = 1024;
constexpr float ALPHA = 1.4142135623730951f, LN_EPS = 1e-6f;
constexpr int KMERGE = 2560;
constexpr int MAXTILES = 98, XSROWS = MAXTILES * 256;
constexpr int NSLAB = 16;
constexpr int NPHASE = 24;

constexpr size_t al256(size_t x) { return (x + 255) / 256 * 256; }
constexpr size_t WS_CTL = 0, CTL_BYTES = 1u << 20;
constexpr size_t WS_MODP = WS_CTL + CTL_BYTES;
constexpr size_t WS_WINT = al256(WS_MODP + (size_t)2 * NSLAB * 2 * 12288 * 4);
constexpr size_t WS_BINP = al256(WS_WINT + (size_t)2 * NWIN * 2048 * 2);
constexpr size_t WS_WMT = al256(WS_BINP + (size_t)2 * NWIN * 4);
constexpr size_t WS_WOT = al256(WS_WMT + (size_t)2 * 2048 * KMERGE * 2);
constexpr size_t WS_WUQT = al256(WS_WOT + (size_t)2 * 2048 * 2048 * 2);
constexpr size_t WS_WUKVT = al256(WS_WUQT + (size_t)2 * 768 * 512 * 2);
constexpr size_t WS_W13T = al256(WS_WUKVT + (size_t)2 * 1024 * 256 * 2);
constexpr size_t WS_W2T = al256(WS_W13T + 256);
constexpr size_t WS_WR2 = al256(WS_W2T + 256);
constexpr size_t WS_FMAT = al256(WS_WR2 + (size_t)2 * 2048 * 64 * 4);
constexpr size_t WS_HN = al256(WS_FMAT + (size_t)512 * 512 * 2);
constexpr size_t WS_ZA = al256(WS_HN + (size_t)NROW * 2048 * 2);
constexpr size_t WS_ZB = al256(WS_ZA + (size_t)NROW * 1024 * 2);
constexpr size_t WS_ZCT = al256(WS_ZB + (size_t)NROW * 512 * 2);
constexpr size_t WS_ZD = al256(WS_ZCT + (size_t)NROW * 512 * 2);
constexpr size_t WS_ZKV = al256(WS_ZD + (size_t)NROW * 512 * 2);
constexpr size_t WS_SQD = al256(WS_ZKV + (size_t)NROW * 256 * 2);
constexpr size_t WS_SQKV = al256(WS_SQD + (size_t)NROW * 8 * 4);
constexpr size_t WS_GATES = al256(WS_SQKV + (size_t)NROW * 4 * 4);
constexpr size_t WS_Q = al256(WS_GATES + (size_t)NROW * 8192 * 2);
constexpr size_t WS_KF = al256(WS_Q + (size_t)NROW * 768 * 2);
constexpr size_t WS_V = al256(WS_KF + (size_t)NROW * 768 * 2);
constexpr size_t WS_GT = al256(WS_V + (size_t)NROW * 512 * 2);
constexpr size_t WS_BR = al256(WS_GT + (size_t)16896 * 512 * 2);
constexpr size_t WS_Y = al256(WS_BR + (size_t)NROW * KMERGE * 2);
constexpr size_t WS_MIX = al256(WS_Y + (size_t)NROW * 2048 * 2);
constexpr size_t WS_XA = al256(WS_MIX + (size_t)NROW * 2048 * 4);
constexpr size_t WS_XB = al256(WS_XA + (size_t)NROW * 2048 * 4);
constexpr size_t WS_H32 = al256(WS_XB + (size_t)NROW * 2048 * 4);
constexpr size_t WS_TOKE = al256(WS_H32 + (size_t)NROW * 2048 * 4);
constexpr size_t WS_TOKG = al256(WS_TOKE + (size_t)NROW * 2 * 4);
constexpr size_t WS_POS = al256(WS_TOKG + (size_t)NROW * 2 * 4);
constexpr size_t WS_ROWG = al256(WS_POS + (size_t)NROW * 2 * 4);
constexpr size_t WS_TILEE = al256(WS_ROWG + (size_t)XSROWS * 4);
constexpr size_t WS_XS = al256(WS_TILEE + 512);
constexpr size_t WS_HS = al256(WS_XS + 256);
constexpr size_t WS_YR = al256(WS_HS + 256);
constexpr size_t WS_HN8 = al256(WS_YR + (size_t)XSROWS * 2048 * 2);
constexpr size_t WS_WG8 = al256(WS_HN8 + (size_t)NROW * 2048);
constexpr size_t WS_W13T8 = al256(WS_WG8 + (size_t)2 * 8192 * 2048);
constexpr size_t WS_W2T8 = al256(WS_W13T8 + (size_t)2 * 32 * 2048 * 2048);
constexpr size_t WS_XS8 = al256(WS_W2T8 + (size_t)2 * 32 * 2048 * 1024);
constexpr size_t WS_HS8 = al256(WS_XS8 + (size_t)XSROWS * 2048);
constexpr size_t WS_H8 = al256(WS_HS8 + (size_t)XSROWS * 1024);
constexpr size_t WS_END = al256(WS_H8 + (size_t)NROW * 2048);
static_assert(WS_END <= (size_t)2147483648u, "d_ws map exceeds 4 x largest tensor");
constexpr int CW_BAR = 4096;

constexpr int RING_BYTES = 131072, MISC_OFF = RING_BYTES + 320, LDS_BYTES = 147456;

#define LDS_WAIT() asm volatile("s_waitcnt lgkmcnt(0)" ::: "memory")
#define VM_WAIT() asm volatile("s_waitcnt vmcnt(0)" ::: "memory")
__device__ __forceinline__ unsigned f2bf(float f) { unsigned u = __builtin_bit_cast(unsigned, f); return (u + 0x7fffu + ((u >> 16) & 1u)) >> 16; }
__device__ __forceinline__ float bf2f(unsigned b) { return __builtin_bit_cast(float, b << 16); }
__device__ __forceinline__ float bflo(unsigned w) { return __builtin_bit_cast(float, w << 16); }
__device__ __forceinline__ float bfhi(unsigned w) { return __builtin_bit_cast(float, w & 0xffff0000u); }
typedef __bf16 bf16x2_t __attribute__((ext_vector_type(2)));
__device__ __forceinline__ unsigned cvt_pk_bf16(float lo, float hi) { const bf16x2_t v = __builtin_convertvector((f32x2){lo, hi}, bf16x2_t); return __builtin_bit_cast(unsigned, v); }
__device__ __forceinline__ unsigned pk_fp8x4(float a, float b, float c, float d) { int r = __builtin_amdgcn_cvt_pk_fp8_f32(a, b, 0, false); r = __builtin_amdgcn_cvt_pk_fp8_f32(c, d, r, true); return (unsigned)r; }
constexpr float H8_SCALE = 4.0f, W8_SCALE = 64.0f, G8_INV = 1.0f / 256.0f, HS8_SCALE = 8.0f, M2_INV = 1.0f / 512.0f;
__device__ __forceinline__ float fsigmoid(float x) { return __builtin_amdgcn_rcpf(1.0f + __builtin_amdgcn_exp2f(-1.4426950408889634f * x)); }
__device__ __forceinline__ float fsilu(float x) { return x * fsigmoid(x); }
__device__ __forceinline__ float fgelu(float x) { return x * fsigmoid(1.5957691216057308f * (x + 0.044715f * x * x * x)); }
__device__ __forceinline__ int launder(int x) { asm volatile("" : "+v"(x)); return x; }
template <int CTRL> __device__ __forceinline__ float dpp_mov(float v) { return __builtin_bit_cast(float, __builtin_amdgcn_update_dpp(0, __builtin_bit_cast(int, v), CTRL, 0xf, 0xf, false)); }
__device__ __forceinline__ float wave_sum(float v) {
    v += dpp_mov<0x121>(v); v += dpp_mov<0x122>(v); v += dpp_mov<0x124>(v); v += dpp_mov<0x128>(v);
    const int iv = __builtin_bit_cast(int, v);
    const float r0 = __builtin_bit_cast(float, __builtin_amdgcn_readlane(iv, 0)), r1 = __builtin_bit_cast(float, __builtin_amdgcn_readlane(iv, 16));
    const float r2 = __builtin_bit_cast(float, __builtin_amdgcn_readlane(iv, 32)), r3 = __builtin_bit_cast(float, __builtin_amdgcn_readlane(iv, 48));
    return (r0 + r1) + (r2 + r3);
}
__device__ __forceinline__ float rope_inv(int i) { return __builtin_amdgcn_exp2f(-1.6609640474436813f * (float)i); }
__host__ __device__ __forceinline__ int ropeperm(int j) { const int qd = j >> 3, i = j & 7; return (qd >> 1) * 16 + (i >> 2) * 8 + (qd & 1) * 4 + (i & 3); }

namespace pg8 {
constexpr int BM = 256, BK = 64, HALF = 128, HTB = HALF * BK * 2, STAGE_BYTES = 8 * HTB, NXCD = 8, WGM = 8;
__host__ __device__ __forceinline__ int lds_byte(int r, int c) { const int st = (r >> 4) * 2 + (c >> 5), rr = r & 15, cc = c & 31, ob = rr * 64 + cc * 2; return st * 1024 + (ob ^ (((ob >> 9) & 1) << 5)); }
__host__ __device__ __forceinline__ void stage_rc(int b, int& R, int& C) { const int st = b / 1024, sb = b % 1024, swz = sb ^ (((sb >> 9) & 1) << 5); R = (st >> 1) * 16 + swz / 64; C = (st & 1) * 32 + (swz % 64) / 2; }
__host__ __device__ __forceinline__ int perm32(int rho) { const int n = rho >> 4, i = rho & 15; return 8 * (i >> 2) + 4 * n + (i & 3); }

struct Unit { int pm, pn, half; };
struct Gemm { const bf16_t* A; const bf16_t* Bt; int K; };

struct RectOrder {
    static constexpr bool GATHER = false;
    __device__ int arow(const Unit&, int) const { return 0; }
    int nM, nN, nwg, G, c, pm0, xpm, xpn0, xn;
    __device__ void init(int nM_, int nN_, int pm0_, int G_, int c_, int xpm_ = 0, int xpn0_ = 0, int xn_ = 0) { nM = nM_; nN = nN_; nwg = nM * nN; G = G_; c = c_; pm0 = pm0_; xpm = xpm_; xpn0 = xpn0_; xn = xn_; }
    __device__ bool next(int i, Unit& u) const {
        long L = (long)i * G + c;
        if (L < nwg) {
            int wgid = (int)L; { const int q = nwg / NXCD, r = nwg % NXCD, xcd = wgid % NXCD, off = wgid / NXCD; wgid = (xcd < r ? xcd * (q + 1) : r * (q + 1) + (xcd - r) * q) + off; }
            const int nig = WGM * nN, gid = wgid / nig, fm = gid * WGM, gsz = (nM - fm) < WGM ? (nM - fm) : WGM;
            u.pm = pm0 + fm + ((wgid % nig) % gsz); u.pn = (wgid % nig) / gsz; u.half = 0; return true;
        }
        L -= nwg;
        if (L < xn) { u.pm = xpm; u.pn = xpn0 + (int)L; u.half = 0; return true; }
        return false;
    }
};
struct MoeOrder {
    static constexpr bool GATHER = false;
    __device__ int arow(const Unit&, int) const { return 0; }
    const int* tile_e; int nunits, G, c;
    __device__ bool next(int i, Unit& u) const {
        if (G == 256) {
            const int T = min(32, (nunits >> 3) - 32 * i); if (T <= 0) return false;
            const int x = c >> 5, s = c & 31, tl = s >> 3, lo = (x * T) >> 3, hi = ((x + 1) * T) >> 3;
            if (tl >= hi - lo) return false;
            u.pm = 32 * i + lo + tl; const int te = tile_e[u.pm]; u.pn = (te & 0xff) * 8 + (s & 7); u.half = te >> 8; return true; }
        const long L = (long)i * G + c; if (L >= nunits) return false;
        u.pm = (int)(L >> 3); const int te = tile_e[u.pm]; u.pn = (te & 0xff) * 8 + (int)(L & 7); u.half = te >> 8; return true;
    }
};

typedef int v8i_t __attribute__((ext_vector_type(8)));
typedef int v4i_t __attribute__((ext_vector_type(4)));
__device__ __forceinline__ v8i_t cat8(bf16x8 lo, bf16x8 hi) { return __builtin_shufflevector(__builtin_bit_cast(v4i_t, lo), __builtin_bit_cast(v4i_t, hi), 0, 1, 2, 3, 4, 5, 6, 7); }
struct MoeGatherOrder : MoeOrder {
    static constexpr bool GATHER = true;
    const int* rowtok;
    __device__ int arow(const Unit& u, int r) const { return rowtok[u.pm * 256 + r]; }
};
template <class Epi, class Sched, bool ALIGN_EPI, bool SP2, bool FP8 = false>
__device__ __forceinline__ void gemm_phase(LAS unsigned char* lds, const Gemm g, const Sched& S, const Epi& E) {
    const int tid = launder((int)threadIdx.x), wid = __builtin_amdgcn_readfirstlane(tid >> 6), lane = tid & 63, wr = wid >> 2, wc = wid & 3, fr = lane & 15, fq = lane >> 4;
    const int K = g.K, nt = K / BK;
    unsigned voffA[2], voffB[2];
#pragma unroll
    for (int i = 0; i < 2; ++i) { int R, C; stage_rc(tid * 16 + i * 8192, R, C); const int Rb = Epi::PERM ? ((R & ~31) + perm32(R & 31)) : R;
        voffA[i] = (unsigned)(R * K + C) * 2u; voffB[i] = (unsigned)(Rb * K + C) * 2u; }
    const size_t kstep = (size_t)(BK * 2);
    const size_t hstep = (size_t)HALF * K * 2;
    const size_t tstep = 2 * hstep;
    const unsigned ldsw = (unsigned)wid * 1024u;
    const int aoff = lds_byte(wr * 64 + fr, fq * 8), boff = lds_byte(wc * 32 + fr, fq * 8);
#define PG8_SA(b, h) (((b) * 2 + (h)) * HTB)
#define PG8_SB(b, h) ((4 + (b) * 2 + (h)) * HTB)
#define PG8_STAGE(bufoff, gbase, voff) do { _Pragma("unroll") for (int _i = 0; _i < 2; ++_i) \
        __builtin_amdgcn_global_load_lds((const unsigned*)((const char*)(gbase) + (voff)[_i]), (LAS unsigned*)(lds + (bufoff) + ldsw + _i * 8192), 16, 0, 0); } while (0)
#define PG8_LDA(dst, b, h) do { _Pragma("unroll") for (int m = 0; m < 4; ++m) _Pragma("unroll") for (int k = 0; k < 2; ++k) dst[m][k] = *(const LAS bf16x8*)(lds + PG8_SA(b, h) + aoff + m * 2048 + k * 1024); } while (0)
#define PG8_LDB(dst, b, h) do { _Pragma("unroll") for (int n = 0; n < 2; ++n) _Pragma("unroll") for (int k = 0; k < 2; ++k) dst[n][k] = *(const LAS bf16x8*)(lds + PG8_SB(b, h) + boff + n * 2048 + k * 1024); } while (0)
#define PG8_MMA(ai, bj, At, Bt) do { __builtin_amdgcn_s_setprio(1); if constexpr (FP8) { asm volatile("s_nop 4" ::: "memory"); _Pragma("unroll") for (int m = 0; m < 4; ++m) _Pragma("unroll") for (int n = 0; n < 2; ++n) \
        { const v8i_t b8_ = cat8(Bt[n][0], Bt[n][1]), a8_ = cat8(At[m][0], At[m][1]); asm volatile("v_mfma_f32_16x16x128_f8f6f4 %0, %1, %2, %0" : "+v"(acc[ai][bj][m][n]) : "v"(b8_), "v"(a8_)); } } else { \
        _Pragma("unroll") for (int m = 0; m < 4; ++m) _Pragma("unroll") for (int n = 0; n < 2; ++n) _Pragma("unroll") for (int k = 0; k < 2; ++k) \
        acc[ai][bj][m][n] = __builtin_amdgcn_mfma_f32_16x16x32_bf16(Bt[n][k], At[m][k], acc[ai][bj][m][n], 0, 0, 0); } __builtin_amdgcn_s_setprio(0); } while (0)
#define PG8_WAIT_V(n) asm volatile("s_waitcnt vmcnt(" #n ")" ::: "memory")
#define PG8_WAIT_L(n) asm volatile("s_waitcnt lgkmcnt(" #n ")" ::: "memory")
#define PG8_BAR __builtin_amdgcn_s_barrier()
#define PG8_SCHED __builtin_amdgcn_sched_barrier(0)
    Unit cur, nxt; int ui = 0;
    if (!S.next(0, cur)) return;
    static_assert(!Sched::GATHER || SP2, "gathered A rows: SP2 loop only");
    unsigned vAc[2][2] = {{0u, 0u}, {0u, 0u}}, vAn[2][2] = {{0u, 0u}, {0u, 0u}};
    int gR[2] = {0, 0}, gC[2] = {0, 0};
    if constexpr (Sched::GATHER) {
#pragma unroll
        for (int i = 0; i < 2; ++i) { stage_rc(tid * 16 + i * 8192, gR[i], gC[i]);
#pragma unroll
            for (int h = 0; h < 2; ++h) vAc[h][i] = (unsigned)(S.arow(cur, h * HALF + gR[i]) * K + gC[i]) * 2u; } }
#define PG8_STGA(bufoff, kptr, h, nx) do { if constexpr (Sched::GATHER) { const bool nx_ = (nx); const unsigned sel_[2] = {nx_ ? vAn[h][0] : vAc[h][0], nx_ ? vAn[h][1] : vAc[h][1]}; PG8_STAGE(bufoff, kptr, sel_); } \
        else { PG8_STAGE(bufoff, (kptr) + (h) * hstep, voffA); } } while (0)
    f32x4 acc[2][2][4][2];
#pragma unroll
    for (int a = 0; a < 2; ++a)
#pragma unroll
        for (int b = 0; b < 2; ++b)
#pragma unroll
            for (int m = 0; m < 4; ++m)
#pragma unroll
                for (int n = 0; n < 2; ++n) acc[a][b][m][n] = (f32x4){0.f, 0.f, 0.f, 0.f};
    bf16x8 At[4][2], B0[2][2], B1[2][2];
    const char* cA = (const char*)g.A + (Sched::GATHER ? (size_t)0 : (size_t)cur.pm * tstep); const char* cB = (const char*)g.Bt + (size_t)cur.pn * tstep;
    if constexpr (SP2) {
        PG8_STAGE(PG8_SB(0, 0), cB, voffB); PG8_STAGE(PG8_SB(0, 1), cB + hstep, voffB); PG8_STGA(PG8_SA(0, 0), cA, 0, false); PG8_STGA(PG8_SA(0, 1), cA, 1, false);
        if (wr == 1) PG8_BAR;
        PG8_WAIT_V(2); PG8_BAR;
        PG8_STAGE(PG8_SB(1, 0), cB + kstep, voffB); PG8_STGA(PG8_SA(1, 0), cA + kstep, 0, false); PG8_STAGE(PG8_SB(1, 1), cB + hstep + kstep, voffB);
        PG8_WAIT_V(6); PG8_BAR;
    } else {
        PG8_STAGE(PG8_SB(0, 0), cB, voffB); PG8_STAGE(PG8_SA(0, 0), cA, voffA); PG8_STAGE(PG8_SB(0, 1), cB + hstep, voffB); PG8_STAGE(PG8_SA(0, 1), cA + hstep, voffA);
        if (wr == 1) PG8_BAR;
        PG8_WAIT_V(4); PG8_BAR;
        PG8_STAGE(PG8_SB(1, 0), cB + kstep, voffB); PG8_STAGE(PG8_SA(1, 0), cA + kstep, voffA); PG8_STAGE(PG8_SB(1, 1), cB + hstep + kstep, voffB);
        PG8_WAIT_V(6); PG8_BAR;
    }
    for (;;) {
        const bool has_next = S.next(ui + 1, nxt);
        if constexpr (Sched::GATHER) { if (has_next) {
#pragma unroll
            for (int i = 0; i < 2; ++i)
#pragma unroll
                for (int h = 0; h < 2; ++h) vAn[h][i] = (unsigned)(S.arow(nxt, h * HALF + gR[i]) * K + gC[i]) * 2u; } }
        const char* nA = has_next ? (const char*)g.A + (Sched::GATHER ? (size_t)0 : (size_t)nxt.pm * tstep) : cA; const char* nB = has_next ? (const char*)g.Bt + (size_t)nxt.pn * tstep : cB;
#pragma nounroll
        for (int t = 0; t < nt; t += 2) {
            const bool last = (t == nt - 2);
            const char* a1 = cA + (size_t)(t + 1) * kstep;
            const char* a2 = last ? nA : cA + (size_t)(t + 2) * kstep; const char* b2 = last ? nB : cB + (size_t)(t + 2) * kstep;
            const char* a3 = a2 + kstep; const char* b3 = b2 + kstep;
            if constexpr (Epi::MID) { if (t == 8 || t == 16 || t == 32) E.mid(acc, cur, t, wr, wc, fr, fq); }
            if constexpr (SP2) {
            const bool nxu = last && has_next;
            PG8_LDB(B0, 0, 0); PG8_LDB(B1, 0, 1); PG8_SCHED; PG8_LDA(At, 0, 0); PG8_STGA(PG8_SA(1, 1), a1, 1, false);
            PG8_WAIT_V(8); PG8_WAIT_L(0); PG8_BAR; PG8_MMA(0, 0, At, B0); PG8_MMA(0, 1, At, B1); PG8_BAR; PG8_SCHED;
            if (!cur.half) PG8_LDA(At, 0, 1); PG8_STAGE(PG8_SB(0, 0), b2, voffB); PG8_STAGE(PG8_SB(0, 1), b2 + hstep, voffB); PG8_STGA(PG8_SA(0, 0), a2, 0, nxu);
            PG8_WAIT_V(8); PG8_WAIT_L(0); PG8_BAR; if (!cur.half) { PG8_MMA(1, 0, At, B0); PG8_MMA(1, 1, At, B1); } PG8_BAR; PG8_SCHED;
            PG8_LDB(B0, 1, 0); PG8_LDB(B1, 1, 1); PG8_SCHED; PG8_LDA(At, 1, 0); PG8_STGA(PG8_SA(0, 1), a2, 1, nxu);
            PG8_WAIT_V(8); PG8_WAIT_L(0); PG8_BAR; PG8_MMA(0, 0, At, B0); PG8_MMA(0, 1, At, B1); PG8_BAR; PG8_SCHED;
            if (!cur.half) PG8_LDA(At, 1, 1); PG8_STAGE(PG8_SB(1, 0), b3, voffB); PG8_STAGE(PG8_SB(1, 1), b3 + hstep, voffB); PG8_STGA(PG8_SA(1, 0), a3, 0, nxu);
            PG8_WAIT_V(8); PG8_WAIT_L(0); PG8_BAR; if (!cur.half) { PG8_MMA(1, 0, At, B0); PG8_MMA(1, 1, At, B1); } PG8_BAR; PG8_SCHED;
            } else {
            PG8_LDB(B0, 0, 0); PG8_SCHED; PG8_LDA(At, 0, 0); PG8_STAGE(PG8_SA(1, 1), a1 + hstep, voffA);
            PG8_WAIT_L(8); PG8_BAR; PG8_WAIT_L(0); PG8_MMA(0, 0, At, B0); PG8_BAR; PG8_SCHED;
            PG8_LDB(B1, 0, 1); PG8_STAGE(PG8_SB(0, 0), b2, voffB);
            PG8_BAR; PG8_WAIT_L(0); PG8_MMA(0, 1, At, B1); PG8_BAR;
            PG8_LDA(At, 0, 1); PG8_STAGE(PG8_SA(0, 0), a2, voffA);
            PG8_BAR; PG8_WAIT_L(0); PG8_MMA(1, 0, At, B0); PG8_BAR; PG8_SCHED;
            PG8_STAGE(PG8_SB(0, 1), b2 + hstep, voffB);
            PG8_WAIT_V(6); PG8_BAR; PG8_MMA(1, 1, At, B1); PG8_BAR;
            PG8_LDB(B0, 1, 0); PG8_SCHED; PG8_LDA(At, 1, 0); PG8_STAGE(PG8_SA(0, 1), a2 + hstep, voffA);
            PG8_WAIT_L(8); PG8_BAR; PG8_WAIT_L(0); PG8_MMA(0, 0, At, B0); PG8_BAR; PG8_SCHED;
            PG8_LDB(B1, 1, 1); PG8_STAGE(PG8_SB(1, 0), b3, voffB);
            PG8_BAR; PG8_WAIT_L(0); PG8_MMA(0, 1, At, B1); PG8_BAR;
            PG8_LDA(At, 1, 1); PG8_STAGE(PG8_SA(1, 0), a3, voffA);
            PG8_BAR; PG8_WAIT_L(0); PG8_MMA(1, 0, At, B0); PG8_BAR; PG8_SCHED;
            PG8_STAGE(PG8_SB(1, 1), b3 + hstep, voffB);
            PG8_WAIT_V(6); PG8_BAR; PG8_MMA(1, 1, At, B1); PG8_BAR;
            }
        }
        if constexpr (ALIGN_EPI) { if (wr == 0) PG8_BAR; }
        if constexpr (FP8) asm volatile("s_nop 15\n\ts_nop 15" ::: "memory");
        E(acc, cur, wr, wc, fr, fq);
        if (!has_next) break;
#pragma unroll
        for (int a = 0; a < 2; ++a)
#pragma unroll
            for (int b = 0; b < 2; ++b)
#pragma unroll
                for (int m = 0; m < 4; ++m)
#pragma unroll
                    for (int n = 0; n < 2; ++n) acc[a][b][m][n] = (f32x4){0.f, 0.f, 0.f, 0.f};
        cur = nxt; cA = nA; cB = nB; ++ui;
        if constexpr (Sched::GATHER) {
#pragma unroll
            for (int i = 0; i < 2; ++i)
#pragma unroll
                for (int h = 0; h < 2; ++h) vAc[h][i] = vAn[h][i]; }
        if constexpr (ALIGN_EPI) { if (wr == 1) PG8_BAR; }
    }
    PG8_WAIT_V(0);
    if constexpr (!ALIGN_EPI) { if (wr == 0) PG8_BAR; }
    PG8_BAR;
#undef PG8_STGA
#undef PG8_SA
#undef PG8_SB
#undef PG8_STAGE
#undef PG8_LDA
#undef PG8_LDB
#undef PG8_MMA
#undef PG8_WAIT_V
#undef PG8_WAIT_L
#undef PG8_BAR
#undef PG8_SCHED
}
}

typedef const f32x4 (&AccRef)[2][2][4][2];
__device__ __forceinline__ u32x4 pack8(f32x4 v0, f32x4 v1) { u32x4 w; w.x = cvt_pk_bf16(v0[0], v0[1]); w.y = cvt_pk_bf16(v0[2], v0[3]); w.z = cvt_pk_bf16(v1[0], v1[1]); w.w = cvt_pk_bf16(v1[2], v1[3]); return w; }

__device__ __forceinline__ void rope8(f32x4& va, f32x4& vb, int gi, int prow, int pcol) {
    const int half = gi >> 1, i0 = (gi & 1) * 4; const float pos = (float)(half ? pcol : prow);
#pragma unroll
    for (int e = 0; e < 4; ++e) { const float rev = pos * rope_inv(i0 + e) * 0.15915494309189535f;
        const float c = __builtin_amdgcn_cosf(rev), s = __builtin_amdgcn_sinf(rev); const float a = va[e], b = vb[e]; va[e] = a * c - b * s; vb[e] = b * c + a * s; }
}

struct EpiWin {
    static constexpr bool PERM = true, MID = false;
    const float* bias; bf16_t *ZA, *ZB, *ZCt, *ZD, *ZKV, *KF, *GATES; float *SQD, *SQKV;
    __device__ __forceinline__ void operator()(AccRef acc, const pg8::Unit& u, int wr, int wc, int fr, int fq) const {
        const int pn = u.pn, row0 = launder(u.pm * 256 + wr * 64 + fr), colt = launder(pn * 256 + wc * 32 + 8 * fq);
        if (pn == 13) {
            if (wc == 0) {
                const f32x4 b0 = *(const f32x4*)(bias + colt), b1 = *(const f32x4*)(bias + colt + 4);
#pragma unroll
                for (int ai = 0; ai < 2; ++ai)
#pragma unroll
                    for (int m = 0; m < 4; ++m) { const int row = row0 + ai * 128 + m * 16;
                        f32x4 v0 = acc[ai][0][m][0] + b0, v1 = acc[ai][0][m][1] + b1;
                        if (row >= CTX) { const int t = row - CTX; rope8(v0, v1, fq, t >> 6, t & 63); }
                        const u32x4 w = pack8(v0, v1);
#pragma unroll
                        for (int h = 0; h < 8; ++h) *(u32x4*)(KF + (size_t)row * 768 + h * 96 + 64 + 8 * fq) = w; }
            }
            return;
        }
        f32x4 bv[2][2];
#pragma unroll
        for (int bj = 0; bj < 2; ++bj)
#pragma unroll
            for (int n = 0; n < 2; ++n) bv[bj][n] = *(const f32x4*)(bias + colt + bj * 128 + 4 * n);
        asm volatile("" : "+v"(bv[0][0]), "+v"(bv[0][1]), "+v"(bv[1][0]), "+v"(bv[1][1]));
        if (pn < 4) {
#pragma unroll
            for (int ai = 0; ai < 2; ++ai)
#pragma unroll
                for (int m = 0; m < 4; ++m) { const int row = row0 + ai * 128 + m * 16;
#pragma unroll
                    for (int bj = 0; bj < 2; ++bj) { f32x4 v0 = acc[ai][bj][m][0] + bv[bj][0], v1 = acc[ai][bj][m][1] + bv[bj][1];
#pragma unroll
                        for (int e = 0; e < 4; ++e) { v0[e] = fgelu(v0[e]); v1[e] = fgelu(v1[e]); }
                        *(u32x4*)(ZA + (size_t)row * 1024 + colt + bj * 128) = pack8(v0, v1); } }
        } else if (pn < 8) {
            const int c0 = (pn - 4) * 128 + wc * 32 + 8 * fq;
#pragma unroll
            for (int ai = 0; ai < 2; ++ai)
#pragma unroll
                for (int m = 0; m < 4; ++m) { const int row = row0 + ai * 128 + m * 16;
                    f32x4 v0 = acc[ai][0][m][0] + bv[0][0], v1 = acc[ai][0][m][1] + bv[0][1], g0 = acc[ai][1][m][0] + bv[1][0], g1 = acc[ai][1][m][1] + bv[1][1];
#pragma unroll
                    for (int e = 0; e < 4; ++e) { v0[e] *= fsigmoid(g0[e]); v1[e] *= fsigmoid(g1[e]); }
                    *(u32x4*)(ZB + (size_t)row * 512 + c0) = pack8(v0, v1); }
        } else if (pn < 10) {
#pragma unroll
            for (int ai = 0; ai < 2; ++ai)
#pragma unroll
                for (int m = 0; m < 4; ++m) { const int row = row0 + ai * 128 + m * 16;
#pragma unroll
                    for (int bj = 0; bj < 2; ++bj) { const int ch = colt + bj * 128 - 2048; const f32x4 v0 = acc[ai][bj][m][0] + bv[bj][0], v1 = acc[ai][bj][m][1] + bv[bj][1];
#pragma unroll
                        for (int e = 0; e < 4; ++e) { ZCt[(size_t)(ch + e) * NROW + row] = (bf16_t)f2bf(v0[e]); ZCt[(size_t)(ch + 4 + e) * NROW + row] = (bf16_t)f2bf(v1[e]); } } }
        } else if (pn < 13) {
            const bool isq = pn < 12; bf16_t* dst = isq ? ZD : ZKV; const int ld = isq ? 512 : 256, cb = colt - (isq ? 2560 : 3072);
#pragma unroll
            for (int ai = 0; ai < 2; ++ai)
#pragma unroll
                for (int m = 0; m < 4; ++m) { const int row = row0 + ai * 128 + m * 16; float ss = 0.f;
#pragma unroll
                    for (int bj = 0; bj < 2; ++bj) { const f32x4 v0 = acc[ai][bj][m][0] + bv[bj][0], v1 = acc[ai][bj][m][1] + bv[bj][1];
#pragma unroll
                        for (int e = 0; e < 4; ++e) ss += v0[e] * v0[e] + v1[e] * v1[e];
                        *(u32x4*)(dst + (size_t)row * ld + cb + bj * 128) = pack8(v0, v1); }
                    { auto r16 = __builtin_amdgcn_permlane16_swap(__float_as_uint(ss), __float_as_uint(ss), false, false); ss = __uint_as_float(r16[0]) + __uint_as_float(r16[1]); }
                    { auto r32s = __builtin_amdgcn_permlane32_swap(__float_as_uint(ss), __float_as_uint(ss), false, false); ss = __uint_as_float(r32s[0]) + __uint_as_float(r32s[1]); }
                    if (fq == 0) { if (isq) SQD[(size_t)row * 8 + (pn - 10) * 4 + wc] = ss; else SQKV[(size_t)row * 4 + wc] = ss; } }
        } else {
            const int cb = colt - 3584;
#pragma unroll
            for (int ai = 0; ai < 2; ++ai)
#pragma unroll
                for (int m = 0; m < 4; ++m) { const int row = row0 + ai * 128 + m * 16;
#pragma unroll
                    for (int bj = 0; bj < 2; ++bj) { f32x4 v0 = acc[ai][bj][m][0] + bv[bj][0], v1 = acc[ai][bj][m][1] + bv[bj][1];
#pragma unroll
                        for (int e = 0; e < 4; ++e) { v0[e] = fsigmoid(v0[e]); v1[e] = fsigmoid(v1[e]); }
                        *(u32x4*)(GATES + (size_t)row * 8192 + cb + bj * 128) = pack8(v0, v1); } }
        }
    }
};

__device__ __forceinline__ size_t gate_idx(int gt, int pm, int ai, int m, int bj, int wave, int lane) { return ((((((size_t)(gt * 33 + pm) * 2 + ai) * 4 + m) * 2 + bj) * 8 + wave) * 64 + lane) * 8; }
__device__ __forceinline__ float gate_rc(const unsigned char* G8, int row, int s, int col) {
    const int pm = row >> 8, rr = row & 255, pn = col >> 8, cc = col & 255;
    const size_t i = gate_idx(s * 8 + pn, pm, rr >> 7, (rr >> 4) & 3, cc >> 7, ((rr >> 6) & 1) * 4 + ((cc >> 5) & 3), ((cc >> 3) & 3) * 16 + (rr & 15)) + (cc & 7);
    return __builtin_amdgcn_cvt_f32_fp8((int)G8[i], 0);
}
__device__ __forceinline__ void gate8_unpack(u32x2 g, float (&o)[8]) {
    const f32x2 a = __builtin_amdgcn_cvt_pk_f32_fp8((int)g.x, false), b = __builtin_amdgcn_cvt_pk_f32_fp8((int)g.x, true), c = __builtin_amdgcn_cvt_pk_f32_fp8((int)g.y, false), d = __builtin_amdgcn_cvt_pk_f32_fp8((int)g.y, true);
    o[0] = a.x; o[1] = a.y; o[2] = b.x; o[3] = b.y; o[4] = c.x; o[5] = c.y; o[6] = d.x; o[7] = d.y;
}
struct EpiGate8 {
    static constexpr bool PERM = true, MID = false;
    const float* bias; unsigned char* GATES;
    __device__ __forceinline__ void operator()(AccRef acc, const pg8::Unit& u, int wr, int wc, int fr, int fq) const {
        const int colt = launder(u.pn * 256 + wc * 32 + 8 * fq);
        f32x4 bv[2][2];
#pragma unroll
        for (int bj = 0; bj < 2; ++bj)
#pragma unroll
            for (int n = 0; n < 2; ++n) bv[bj][n] = *(const f32x4*)(bias + colt + bj * 128 + 4 * n);
#pragma unroll
        for (int ai = 0; ai < 2; ++ai)
#pragma unroll
            for (int m = 0; m < 4; ++m) {
#pragma unroll
                for (int bj = 0; bj < 2; ++bj) { f32x4 v0 = acc[ai][bj][m][0] * G8_INV + bv[bj][0], v1 = acc[ai][bj][m][1] * G8_INV + bv[bj][1];
#pragma unroll
                    for (int e = 0; e < 4; ++e) { v0[e] = fmaxf(fsigmoid(v0[e]), 0.00390625f); v1[e] = fmaxf(fsigmoid(v1[e]), 0.00390625f); }
                    u32x2 w; w.x = pk_fp8x4(v0[0], v0[1], v0[2], v0[3]); w.y = pk_fp8x4(v1[0], v1[1], v1[2], v1[3]);
                    *(u32x2*)(GATES + gate_idx(u.pn, u.pm, ai, m, bj, wr * 4 + wc, fq * 16 + fr)) = w; } }
    }
};
struct EpiQ {
    static constexpr bool PERM = true, MID = false;
    const float* SQD; bf16_t* Q;
    __device__ __forceinline__ void operator()(AccRef acc, const pg8::Unit& u, int wr, int wc, int fr, int fq) const {
        const int row0 = launder(u.pm * 256 + wr * 64 + fr), colt = launder(u.pn * 256 + wc * 32 + 8 * fq);
#pragma unroll
        for (int ai = 0; ai < 2; ++ai)
#pragma unroll
            for (int m = 0; m < 4; ++m) { const int row = row0 + ai * 128 + m * 16;
                const f32x4 s0 = *(const f32x4*)(SQD + (size_t)row * 8), s1 = *(const f32x4*)(SQD + (size_t)row * 8 + 4);
                const float ss = ((s0[0] + s0[1]) + (s0[2] + s0[3])) + ((s1[0] + s1[1]) + (s1[2] + s1[3]));
                const float rs = 1.0f / sqrtf(ss * (1.0f / 512.0f) + LN_EPS);
#pragma unroll
                for (int bj = 0; bj < 2; ++bj) { const int col = colt + bj * 128, d8 = col % 96;
                    f32x4 v0 = acc[ai][bj][m][0] * rs, v1 = acc[ai][bj][m][1] * rs;
                    if (row >= CTX && d8 >= 64) { const int t = row - CTX; rope8(v0, v1, (d8 - 64) >> 3, t >> 6, t & 63); }
                    *(u32x4*)(Q + (size_t)row * 768 + col) = pack8(v0, v1); } }
    }
};
struct EpiKV {
    static constexpr bool PERM = true, MID = false;
    const float* SQKV; bf16_t *KF, *V;
    __device__ __forceinline__ void operator()(AccRef acc, const pg8::Unit& u, int wr, int wc, int fr, int fq) const {
        const int row0 = launder(u.pm * 256 + wr * 64 + fr), colt = launder(u.pn * 256 + wc * 32 + 8 * fq);
        const bool isK = u.pn < 2; bf16_t* base = isK ? KF : V; const int ld = isK ? 768 : 512, cstep = isK ? 192 : 128, coff = isK ? ((colt >> 6) * 96 + (colt & 63)) : colt - 512;
#pragma unroll
        for (int ai = 0; ai < 2; ++ai)
#pragma unroll
            for (int m = 0; m < 4; ++m) { const int row = row0 + ai * 128 + m * 16;
                const f32x4 s0 = *(const f32x4*)(SQKV + (size_t)row * 4);
                const float rs = 1.0f / sqrtf(((s0[0] + s0[1]) + (s0[2] + s0[3])) * (1.0f / 256.0f) + LN_EPS);
#pragma unroll
                for (int bj = 0; bj < 2; ++bj) { const f32x4 v0 = acc[ai][bj][m][0] * rs, v1 = acc[ai][bj][m][1] * rs;
                    *(u32x4*)(base + (size_t)row * ld + coff + bj * cstep) = pack8(v0, v1); } }
    }
};
struct EpiF2 {
    static constexpr bool PERM = true, MID = false;
    bf16_t* BR;
    __device__ __forceinline__ void operator()(AccRef acc, const pg8::Unit& u, int wr, int wc, int fr, int fq) const {
        const int po = u.pm, k10 = launder(wr * 64 + fr), colt = launder(u.pn * 256 + wc * 32 + 8 * fq);
#pragma unroll
        for (int ai = 0; ai < 2; ++ai)
#pragma unroll
            for (int m = 0; m < 4; ++m) { const int k1 = k10 + ai * 128 + m * 16;
#pragma unroll
                for (int bj = 0; bj < 2; ++bj) { const int j = colt + bj * 128; int row, ch;
                    if (j < 16384) { ch = j & 511; row = CTX + 32 * k1 + (j >> 9); } else { ch = j - 16384; row = k1; }
                    *(u32x4*)(BR + (size_t)row * KMERGE + 1024 + (ch >> 7) * 256 + po * 128 + (ch & 127)) = pack8(acc[ai][bj][m][0], acc[ai][bj][m][1]); } }
    }
};
struct EpiMerge {
    static constexpr bool PERM = true, MID = true;
    const unsigned char* GATES; bf16_t* Y;
    __device__ __forceinline__ void mid(f32x4 (&acc)[2][2][4][2], const pg8::Unit& u, int t, int wr, int wc, int fr, int fq) const {
        const int s = (t == 8) ? 0 : ((t == 16) ? 1 : 2);
        const int wv = launder(wr * 4 + wc), ln = launder(fq * 16 + fr);
#pragma unroll
        for (int ai = 0; ai < 2; ++ai)
#pragma unroll
            for (int m = 0; m < 4; ++m)
#pragma unroll
                for (int bj = 0; bj < 2; ++bj) { const u32x2 ga = *(const u32x2*)(GATES + gate_idx(s * 8 + u.pn, u.pm, ai, m, bj, wv, ln)), gb = *(const u32x2*)(GATES + gate_idx((s + 1) * 8 + u.pn, u.pm, ai, m, bj, wv, ln));
                    float fa[8], fb[8]; gate8_unpack(ga, fa); gate8_unpack(gb, fb);
#pragma unroll
                    for (int q = 0; q < 8; ++q) acc[ai][bj][m][q >> 2][q & 3] *= fa[q] * __builtin_amdgcn_rcpf(fmaxf(fb[q], 1e-30f)); }
    }
    __device__ __forceinline__ void operator()(AccRef acc, const pg8::Unit& u, int wr, int wc, int fr, int fq) const {
        const int row0 = launder(u.pm * 256 + wr * 64 + fr), colt = launder(u.pn * 256 + wc * 32 + 8 * fq);
#pragma unroll
        for (int ai = 0; ai < 2; ++ai)
#pragma unroll
            for (int m = 0; m < 4; ++m) { const int row = row0 + ai * 128 + m * 16;
#pragma unroll
                for (int bj = 0; bj < 2; ++bj) { const u32x2 g = *(const u32x2*)(GATES + gate_idx(24 + u.pn, u.pm, ai, m, bj, wr * 4 + wc, fq * 16 + fr));
                    float fg[8]; gate8_unpack(g, fg);
                    f32x4 v0 = acc[ai][bj][m][0], v1 = acc[ai][bj][m][1];
#pragma unroll
                    for (int q = 0; q < 4; ++q) { v0[q] *= fg[q]; v1[q] *= fg[4 + q]; }
                    *(u32x4*)(Y + (size_t)row * 2048 + colt + bj * 128) = pack8(v0, v1); } }
    }
};
struct EpiWo {
    static constexpr bool PERM = true, MID = false;
    bf16_t* MIX;
    __device__ __forceinline__ void operator()(AccRef acc, const pg8::Unit& u, int wr, int wc, int fr, int fq) const {
        const int row0 = launder(u.pm * 256 + wr * 64 + fr), colt = launder(u.pn * 256 + wc * 32 + 8 * fq);
#pragma unroll
        for (int ai = 0; ai < 2; ++ai)
#pragma unroll
            for (int m = 0; m < 4; ++m) { bf16_t* rowp = MIX + (size_t)(row0 + ai * 128 + m * 16) * 2048 + colt;
#pragma unroll
                for (int bj = 0; bj < 2; ++bj) *(u32x4*)(rowp + bj * 128) = pack8(acc[ai][bj][m][0], acc[ai][bj][m][1]); }
    }
};
struct EpiMoe1 {
    static constexpr bool PERM = true, MID = false;
    bf16_t* HS;
    __device__ __forceinline__ void operator()(AccRef acc, const pg8::Unit& u, int wr, int wc, int fr, int fq) const {
        const int row0 = launder(u.pm * 256 + wr * 64 + fr), c0 = launder((u.pn & 7) * 128 + wc * 32 + 8 * fq);
#pragma unroll
        for (int ai = 0; ai < 2; ++ai)
#pragma unroll
            for (int m = 0; m < 4; ++m) { f32x4 v0 = acc[ai][0][m][0], v1 = acc[ai][0][m][1]; const f32x4 g0 = acc[ai][1][m][0], g1 = acc[ai][1][m][1];
#pragma unroll
                for (int e = 0; e < 4; ++e) { v0[e] = fsilu(v0[e]) * g0[e]; v1[e] = fsilu(v1[e]) * g1[e]; }
                *(u32x4*)(HS + (size_t)(row0 + ai * 128 + m * 16) * 1024 + c0) = pack8(v0, v1); }
    }
};
struct EpiMoe1F8 {
    static constexpr bool PERM = true, MID = false;
    unsigned char* HS8;
    __device__ __forceinline__ void operator()(AccRef acc, const pg8::Unit& u, int wr, int wc, int fr, int fq) const {
        const int row0 = launder(u.pm * 256 + wr * 64 + fr), c0 = launder((u.pn & 7) * 128 + wc * 32 + 8 * fq);
#pragma unroll
        for (int ai = 0; ai < 2; ++ai)
#pragma unroll
            for (int m = 0; m < 4; ++m) { f32x4 v0 = acc[ai][0][m][0] * G8_INV, v1 = acc[ai][0][m][1] * G8_INV; const f32x4 g0 = acc[ai][1][m][0] * (G8_INV * HS8_SCALE), g1 = acc[ai][1][m][1] * (G8_INV * HS8_SCALE);
#pragma unroll
                for (int e = 0; e < 4; ++e) { v0[e] = fsilu(v0[e]) * g0[e]; v1[e] = fsilu(v1[e]) * g1[e]; }
                u32x2 w; w.x = pk_fp8x4(v0[0], v0[1], v0[2], v0[3]); w.y = pk_fp8x4(v1[0], v1[1], v1[2], v1[3]);
                *(u32x2*)(HS8 + (size_t)(row0 + ai * 128 + m * 16) * 1024 + c0) = w; }
    }
};
struct EpiMoe2 {
    static constexpr bool PERM = true, MID = false;
    const float* ROWG; bf16_t* YR;
    __device__ __forceinline__ void operator()(AccRef acc, const pg8::Unit& u, int wr, int wc, int fr, int fq) const {
        const int row0 = launder(u.pm * 256 + wr * 64 + fr), colt = launder((u.pn & 7) * 256 + wc * 32 + 8 * fq);
#pragma unroll
        for (int ai = 0; ai < 2; ++ai)
#pragma unroll
            for (int m = 0; m < 4; ++m) { const int row = row0 + ai * 128 + m * 16; const float gt = ROWG[row] * M2_INV;
#pragma unroll
                for (int bj = 0; bj < 2; ++bj) *(u32x4*)(YR + (size_t)row * 2048 + colt + bj * 128) = pack8(acc[ai][bj][m][0] * gt, acc[ai][bj][m][1] * gt); }
    }
};

template <bool MERGE>
__device__ __forceinline__ void ctx_gemm(const bf16_t* __restrict__ A, const bf16_t* __restrict__ Bt, int unit, const unsigned char* __restrict__ GATES, bf16_t* __restrict__ Y, bf16_t* __restrict__ MIX, LAS float* red) {
    constexpr int K = MERGE ? KMERGE : 2048, PER = K / 32 / 8, CH = MERGE ? 5 : 4;
    const int tid = launder((int)threadIdx.x), lane = tid & 63, w = __builtin_amdgcn_readfirstlane(tid >> 6), fr = lane & 15, fq = lane >> 4;
    const int row0 = (unit & 7) * 32, col0 = (unit >> 3) * 64, s0 = w * PER;
    const bf16_t* ap = A + (size_t)(row0 + fr) * K + s0 * 32 + fq * 8;
    const bf16_t* bp = Bt + (size_t)(col0 + fr) * K + s0 * 32 + fq * 8;
    f32x4 acc[2][4];
#pragma unroll
    for (int rb = 0; rb < 2; ++rb)
#pragma unroll
        for (int cb = 0; cb < 4; ++cb) acc[rb][cb] = (f32x4){0.f, 0.f, 0.f, 0.f};
#pragma nounroll
    for (int t0 = 0; t0 < PER; t0 += CH) {
        bf16x8 a[2][CH], b[4][CH];
#pragma unroll
        for (int t = 0; t < CH; ++t) {
#pragma unroll
            for (int rb = 0; rb < 2; ++rb) a[rb][t] = *(const bf16x8*)(ap + (size_t)(16 * rb) * K + (t0 + t) * 32);
#pragma unroll
            for (int cb = 0; cb < 4; ++cb) b[cb][t] = *(const bf16x8*)(bp + (size_t)(16 * cb) * K + (t0 + t) * 32); }
#pragma unroll
        for (int t = 0; t < CH; ++t) {
            if (MERGE) { const int st = s0 + t0 + t;
                if ((st == 16 || st == 32 || st == 64) && st != s0) { const int sg = (st == 16) ? 0 : ((st == 32) ? 1 : 2);
#pragma unroll
                    for (int rb = 0; rb < 2; ++rb)
#pragma unroll
                        for (int cb = 0; cb < 4; ++cb)
#pragma unroll
                            for (int i = 0; i < 4; ++i) { const int rw = row0 + 16 * rb + 4 * fq + i, cl = col0 + 16 * cb + fr;
                                acc[rb][cb][i] *= gate_rc(GATES, rw, sg, cl) * __builtin_amdgcn_rcpf(fmaxf(gate_rc(GATES, rw, sg + 1, cl), 1e-30f)); } } }
#pragma unroll
            for (int rb = 0; rb < 2; ++rb)
#pragma unroll
                for (int cb = 0; cb < 4; ++cb) acc[rb][cb] = __builtin_amdgcn_mfma_f32_16x16x32_bf16(a[rb][t], b[cb][t], acc[rb][cb], 0, 0, 0); }
    }
    if (MERGE) { const int sl = s0 + PER - 1, sg = sl < 16 ? 0 : (sl < 32 ? 1 : (sl < 64 ? 2 : 3));
#pragma unroll
        for (int rb = 0; rb < 2; ++rb)
#pragma unroll
            for (int cb = 0; cb < 4; ++cb)
#pragma unroll
                for (int i = 0; i < 4; ++i) acc[rb][cb][i] *= gate_rc(GATES, row0 + 16 * rb + 4 * fq + i, sg, col0 + 16 * cb + fr); }
#pragma unroll
    for (int rb = 0; rb < 2; ++rb)
#pragma unroll
        for (int cb = 0; cb < 4; ++cb)
#pragma unroll
            for (int i = 0; i < 4; ++i) red[(w * 32 + 16 * rb + 4 * fq + i) * 64 + 16 * cb + fr] = acc[rb][cb][i];
    __syncthreads();
    { const int r = tid >> 4, c4 = (tid & 15) * 4; f32x4 sacc = {0.f, 0.f, 0.f, 0.f};
#pragma unroll
      for (int ww = 0; ww < 8; ++ww) sacc += *(const LAS f32x4*)(red + (ww * 32 + r) * 64 + c4);
      u32x2 o; o.x = cvt_pk_bf16(sacc[0], sacc[1]); o.y = cvt_pk_bf16(sacc[2], sacc[3]); *(u32x2*)((MERGE ? Y : MIX) + (size_t)(row0 + r) * 2048 + col0 + c4) = o; }
    __syncthreads();
}

namespace attn {
constexpr int QBLK = 32, KVBLK = 64;
constexpr float SCALE = 0.10206207261596575f, THR = 8.f;
constexpr int SHM_V = 16384, SHM_K = 16384, SHM_ATTN = 2 * SHM_V + 2 * SHM_K + 8 * 64 * 4;
#define KSWZ(row, colB) ((row) * 256 + ((colB) ^ (((row) & 7) << 4)))
#define SBAR() __builtin_amdgcn_sched_barrier(0)
__device__ __forceinline__ int crow(int r, int hi) { return (r & 3) + 8 * (r >> 2) + 4 * hi; }
__device__ __forceinline__ void partialSM(f32x16& p0, f32x16& p1, float& m_reg, float& mn, float& alpha) {
    constexpr float C = SCALE * 1.4426950408889634f;
    float pmax = p0[0];
#pragma unroll
    for (int r = 1; r < 16; ++r) pmax = fmaxf(pmax, p0[r]);
#pragma unroll
    for (int r = 0; r < 16; ++r) pmax = fmaxf(pmax, p1[r]);
    { auto rr = __builtin_amdgcn_permlane32_swap(__float_as_uint(pmax), __float_as_uint(pmax), false, false);
      pmax = fmaxf(__uint_as_float(rr[0]), __uint_as_float(rr[1])); }
    if (__builtin_expect(__all(pmax - m_reg <= THR / SCALE), 1)) { mn = m_reg; alpha = 1.f; }
    else { mn = fmaxf(m_reg, pmax); alpha = __builtin_amdgcn_exp2f((m_reg - mn) * C); m_reg = mn; }
    const float mnC = -mn * C;
#pragma unroll
    for (int r = 0; r < 16; ++r) p0[r] = fmaf(p0[r], C, mnC);
#pragma unroll
    for (int r = 0; r < 16; ++r) p1[r] = fmaf(p1[r], C, mnC);
#pragma unroll
    for (int r = 0; r < 16; ++r) p0[r] = __builtin_amdgcn_exp2f(p0[r]);
}
__device__ __forceinline__ void finishSM(f32x16& p0, f32x16& p1, float alpha, float& l_reg, bf16x8& pa0, bf16x8& pa1, bf16x8& pa2, bf16x8& pa3) {
#pragma unroll
    for (int r = 0; r < 16; ++r) p1[r] = __builtin_amdgcn_exp2f(p1[r]);
    float ps = 0;
#pragma unroll
    for (int r = 0; r < 16; ++r) ps += p0[r];
#pragma unroll
    for (int r = 0; r < 16; ++r) ps += p1[r];
    { auto rr = __builtin_amdgcn_permlane32_swap(__float_as_uint(ps), __float_as_uint(ps), false, false);
      ps = __uint_as_float(rr[0]) + __uint_as_float(rr[1]); }
    l_reg = l_reg * alpha + ps;
#define PK4(P, BASE, OUT) do { unsigned a0 = cvt_pk_bf16(P[BASE + 0], P[BASE + 1]), a1 = cvt_pk_bf16(P[BASE + 2], P[BASE + 3]);   \
    unsigned b0 = cvt_pk_bf16(P[BASE + 4], P[BASE + 5]), b1 = cvt_pk_bf16(P[BASE + 6], P[BASE + 7]);                              \
    auto r0 = __builtin_amdgcn_permlane32_swap(a0, b0, false, false); auto r1 = __builtin_amdgcn_permlane32_swap(a1, b1, false, false); \
    u32x4 w = {r0[0], r1[0], r0[1], r1[1]}; OUT = __builtin_bit_cast(bf16x8, w); } while (0)
    PK4(p0, 0, pa0); PK4(p0, 8, pa1); PK4(p1, 0, pa2); PK4(p1, 8, pa3);
#undef PK4
}
__device__ __forceinline__ void qkt(f32x16& p0, f32x16& p1, const LAS unsigned char* Ks, const bf16x8 (&qr)[6], int r32, int hi) {
    p0 = f32x16{}; p1 = f32x16{};
#pragma unroll
    for (int d0 = 0; d0 < 6; ++d0) { const int cb = (d0 * 16 + hi * 8) * 2;
        const bf16x8 b0 = *(const LAS bf16x8*)(Ks + KSWZ(r32, cb));
        const bf16x8 b1 = *(const LAS bf16x8*)(Ks + KSWZ(32 + r32, cb));
        p0 = __builtin_amdgcn_mfma_f32_32x32x16_bf16(b0, qr[d0], p0, 0, 0, 0);
        p1 = __builtin_amdgcn_mfma_f32_32x32x16_bf16(b1, qr[d0], p1, 0, 0, 0); }
}
__device__ __forceinline__ int v_st(int k, int c) { const int kk = (k & ~0xC) | ((k & 4) << 1) | ((k & 8) >> 1); return ((kk >> 3) * 4 + (c >> 5)) * 512 + ((kk & 7) * 32 + (c & 31)) * 2; }
__device__ __forceinline__ int v_rd_base(int lane) { return ((lane & 3) << 3) | (((lane >> 2) & 3) << 6) | (((lane >> 4) & 1) << 5) | (((lane >> 5) & 1) << 8); }
constexpr int v_rd_off(int d0, int ks, int half) { return d0 * 512 + ks * 4096 + half * 2048; }
template <int OFF> __device__ __forceinline__ s16x4 tr_read(int vb) {
    s16x4 r; asm volatile("ds_read_b64_tr_b16 %0, %1 offset:%2" : "=&v"(r) : "v"(vb), "i"(OFF) : "memory"); return r;
}
template <int D0> __device__ __forceinline__ void pv_one(f32x16& od, int vb, bf16x8 pa0, bf16x8 pa1, bf16x8 pa2, bf16x8 pa3) {
    const s16x4 l0 = tr_read<v_rd_off(D0, 0, 0)>(vb), h0 = tr_read<v_rd_off(D0, 0, 1)>(vb), l1 = tr_read<v_rd_off(D0, 1, 0)>(vb), h1 = tr_read<v_rd_off(D0, 1, 1)>(vb);
    const s16x4 l2 = tr_read<v_rd_off(D0, 2, 0)>(vb), h2 = tr_read<v_rd_off(D0, 2, 1)>(vb), l3 = tr_read<v_rd_off(D0, 3, 0)>(vb), h3 = tr_read<v_rd_off(D0, 3, 1)>(vb);
    asm volatile("s_waitcnt lgkmcnt(0)" ::: "memory"); SBAR();
#define PK(L, H) (bf16x8){L[0], L[1], L[2], L[3], H[0], H[1], H[2], H[3]}
    od = __builtin_amdgcn_mfma_f32_32x32x16_bf16(pa0, PK(l0, h0), od, 0, 0, 0);
    od = __builtin_amdgcn_mfma_f32_32x32x16_bf16(pa1, PK(l1, h1), od, 0, 0, 0);
    od = __builtin_amdgcn_mfma_f32_32x32x16_bf16(pa2, PK(l2, h2), od, 0, 0, 0);
    od = __builtin_amdgcn_mfma_f32_32x32x16_bf16(pa3, PK(l3, h3), od, 0, 0, 0);
#undef PK
}
__device__ __forceinline__ void pv_both(f32x16& o0, f32x16& o1, int vb, bf16x8 pa0, bf16x8 pa1, bf16x8 pa2, bf16x8 pa3) {
    const s16x4 a0 = tr_read<v_rd_off(0, 0, 0)>(vb), b0 = tr_read<v_rd_off(0, 0, 1)>(vb), a1 = tr_read<v_rd_off(0, 1, 0)>(vb), b1 = tr_read<v_rd_off(0, 1, 1)>(vb);
    const s16x4 a2 = tr_read<v_rd_off(0, 2, 0)>(vb), b2 = tr_read<v_rd_off(0, 2, 1)>(vb), a3 = tr_read<v_rd_off(0, 3, 0)>(vb), b3 = tr_read<v_rd_off(0, 3, 1)>(vb);
    const s16x4 c0 = tr_read<v_rd_off(1, 0, 0)>(vb), d0 = tr_read<v_rd_off(1, 0, 1)>(vb), c1 = tr_read<v_rd_off(1, 1, 0)>(vb), d1 = tr_read<v_rd_off(1, 1, 1)>(vb);
    const s16x4 c2 = tr_read<v_rd_off(1, 2, 0)>(vb), d2 = tr_read<v_rd_off(1, 2, 1)>(vb), c3 = tr_read<v_rd_off(1, 3, 0)>(vb), d3 = tr_read<v_rd_off(1, 3, 1)>(vb);
    asm volatile("s_waitcnt lgkmcnt(0)" ::: "memory"); SBAR();
#define PK(L, H) (bf16x8){L[0], L[1], L[2], L[3], H[0], H[1], H[2], H[3]}
    o0 = __builtin_amdgcn_mfma_f32_32x32x16_bf16(pa0, PK(a0, b0), o0, 0, 0, 0);
    o1 = __builtin_amdgcn_mfma_f32_32x32x16_bf16(pa0, PK(c0, d0), o1, 0, 0, 0);
    o0 = __builtin_amdgcn_mfma_f32_32x32x16_bf16(pa1, PK(a1, b1), o0, 0, 0, 0);
    o1 = __builtin_amdgcn_mfma_f32_32x32x16_bf16(pa1, PK(c1, d1), o1, 0, 0, 0);
    o0 = __builtin_amdgcn_mfma_f32_32x32x16_bf16(pa2, PK(a2, b2), o0, 0, 0, 0);
    o1 = __builtin_amdgcn_mfma_f32_32x32x16_bf16(pa2, PK(c2, d2), o1, 0, 0, 0);
    o0 = __builtin_amdgcn_mfma_f32_32x32x16_bf16(pa3, PK(a3, b3), o0, 0, 0, 0);
    o1 = __builtin_amdgcn_mfma_f32_32x32x16_bf16(pa3, PK(c3, d3), o1, 0, 0, 0);
#undef PK
}
__device__ __forceinline__ void attn_unit(const bf16_t* __restrict__ Qb, const bf16_t* __restrict__ Kh, const bf16_t* __restrict__ Vh, bf16_t* __restrict__ Ob, int seq, LAS unsigned char* lds) {
    const int tid = launder((int)threadIdx.x), wid = tid >> 6, lane = tid & 63, r32 = lane & 31, hi = lane >> 5;
    LAS unsigned char* V_lds = lds; LAS unsigned char* K_lds = lds + 2 * SHM_V;
    LAS float* ws = (LAS float*)(lds + 2 * SHM_V + 2 * SHM_K) + wid * 64; LAS float* li_l = ws; LAS float* al_l = ws + 32;
    float m_reg = -1e30f, l_reg = 0; f32x16 o[2] = {}; bf16x8 qr[6];
    { const unsigned qoff = (unsigned)((wid * QBLK + r32) * 768 + hi * 8) * 2u;
#pragma unroll
      for (int d0 = 0; d0 < 6; ++d0) qr[d0] = *(const bf16x8*)((const char*)Qb + qoff + d0 * 32); }
    const int sr = tid >> 4, sc = (tid & 15) * 8; const bool kact = sc < 96, vact = sc < 64; const int sck = kact ? sc : 0, scv = vact ? sc : 0;
    const int vst0 = v_st(sr, scv), vst1 = v_st(32 + sr, scv);
    const int vb0 = (int)(uintptr_t)V_lds + v_rd_base(lane);
    struct { bf16x8 vs0, vs1, ks0, ks1; } sr_[2];
    const unsigned koff0 = (unsigned)(sr * 768 + sck) * 2u, koff1 = koff0 + 32u * 1536u, voff0 = (unsigned)(sr * 512 + scv) * 2u, voff1 = voff0 + 32u * 1024u;
#define SLOAD(i, k0) do { const char* kb_ = (const char*)Kh + (size_t)(k0) * 1536; const char* vb_ = (const char*)Vh + (size_t)(k0) * 1024; \
    sr_[i].vs0 = *(const bf16x8*)(vb_ + voff0); sr_[i].vs1 = *(const bf16x8*)(vb_ + voff1); sr_[i].ks0 = *(const bf16x8*)(kb_ + koff0); sr_[i].ks1 = *(const bf16x8*)(kb_ + koff1); } while (0)
#define SWRITE(b, i) do { if (vact) { *(LAS bf16x8*)(V_lds + (b) * SHM_V + vst0) = sr_[i].vs0; *(LAS bf16x8*)(V_lds + (b) * SHM_V + vst1) = sr_[i].vs1; } \
    if (kact) { const int kc = sc * 2; *(LAS bf16x8*)(K_lds + (b) * SHM_K + KSWZ(sr, kc)) = sr_[i].ks0; *(LAS bf16x8*)(K_lds + (b) * SHM_K + KSWZ(32 + sr, kc)) = sr_[i].ks1; } } while (0)
#define SWAIT() asm volatile("s_waitcnt vmcnt(4)" ::: "memory")
#define RESC(a) do { if (__any((a) < 1.f)) { if (hi == 0) al_l[r32] = (a); asm volatile("s_waitcnt lgkmcnt(0)" ::: "memory"); \
    _Pragma("unroll") for (int d = 0; d < 2; ++d) _Pragma("unroll") for (int r = 0; r < 16; ++r) o[d][r] *= al_l[crow(r, hi)]; } } while (0)
    f32x16 pA0, pA1, pB0, pB1; float mnA, mnB, alA, alB; bf16x8 pa0, pa1, pa2, pa3; const int NT = seq / KVBLK;
    constexpr int SE = 0, SO = 1;
    if (__builtin_amdgcn_readfirstlane(wid) >= 4) __builtin_amdgcn_s_setprio(1);
    SLOAD(SE, 0); asm volatile("s_waitcnt vmcnt(0)" ::: "memory"); SWRITE(0, SE); __syncthreads();
    qkt(pA0, pA1, K_lds, qr, r32, hi); partialSM(pA0, pA1, m_reg, mnA, alA);
    SLOAD(SO, KVBLK); if (2 < NT) SLOAD(SE, 2 * KVBLK);
    SWAIT(); SWRITE(1, SO); __syncthreads();
    for (int j = 1; j + 1 < NT; j += 2) {
        SBAR(); qkt(pB0, pB1, K_lds + SHM_K, qr, r32, hi);
        finishSM(pA0, pA1, alA, l_reg, pa0, pa1, pa2, pa3); SBAR();
        SLOAD(SO, (j + 2) * KVBLK); SBAR();
        pv_both(o[0], o[1], vb0, pa0, pa1, pa2, pa3); partialSM(pB0, pB1, m_reg, mnB, alB);
        __syncthreads(); SWAIT(); SWRITE(0, SE);
        RESC(alB); __syncthreads();
        SBAR(); qkt(pA0, pA1, K_lds, qr, r32, hi);
        finishSM(pB0, pB1, alB, l_reg, pa0, pa1, pa2, pa3); SBAR();
        if (j + 3 < NT) SLOAD(SE, (j + 3) * KVBLK); SBAR();
        pv_both(o[0], o[1], vb0 + SHM_V, pa0, pa1, pa2, pa3); partialSM(pA0, pA1, m_reg, mnA, alA);
        __syncthreads(); SWAIT(); SWRITE(1, SO);
        RESC(alA); __syncthreads();
    }
    SBAR(); qkt(pB0, pB1, K_lds + SHM_K, qr, r32, hi);
    finishSM(pA0, pA1, alA, l_reg, pa0, pa1, pa2, pa3); SBAR();
    pv_both(o[0], o[1], vb0, pa0, pa1, pa2, pa3); partialSM(pB0, pB1, m_reg, mnB, alB);
    __syncthreads(); RESC(alB);
    finishSM(pB0, pB1, alB, l_reg, pa0, pa1, pa2, pa3); SBAR();
    pv_both(o[0], o[1], vb0 + SHM_V, pa0, pa1, pa2, pa3);
    __builtin_amdgcn_s_setprio(0);
    if (hi == 0) li_l[r32] = l_reg; asm volatile("s_waitcnt lgkmcnt(0)" ::: "memory");
    { const unsigned ooff = (unsigned)launder((wid * QBLK + 4 * hi) * KMERGE + r32) * 2u;
#pragma unroll
      for (int r = 0; r < 16; ++r) { const int orow = crow(r, hi); const float rl = __builtin_amdgcn_rcpf(li_l[orow]);
#pragma unroll
        for (int d0 = 0; d0 < 2; ++d0) *(bf16_t*)((char*)Ob + ooff + (unsigned)(((r & 3) + 8 * (r >> 2)) * KMERGE + d0 * 32) * 2u) = (bf16_t)f2bf(o[d0][r] * rl); } }
    __syncthreads();
#undef SLOAD
#undef SWRITE
#undef SWAIT
#undef RESC
}
}

#define XB_TMO      128
#define XB_XCNT(j)  (256  + 64 * (j))
#define XB_XSUB(j)  (1280 + 64 * (j))
#define XB_XGEN(j)  (2304 + 64 * (j))
#define XB_TOP      3328
#define XB_TOPGEN   3392
#define XCD_BAR_WORDS 3456
#define XB_SPIN_CAP (1u << 18)
__device__ __forceinline__ unsigned xb_ld(unsigned* p)              { return __hip_atomic_load(p, __ATOMIC_RELAXED, __HIP_MEMORY_SCOPE_AGENT); }
__device__ __forceinline__ unsigned xb_add(unsigned* p, unsigned v) { return __hip_atomic_fetch_add(p, v, __ATOMIC_RELAXED, __HIP_MEMORY_SCOPE_AGENT); }
__device__ __forceinline__ unsigned xb_xcc_id() { return (unsigned)__builtin_amdgcn_s_getreg((3 << 11) | 20) & 0xFu; }
#define XB_SPIN(cond, bar) do { unsigned _sp = 0; while (cond) { __builtin_amdgcn_s_sleep(1); \
    if ((++_sp & 255u) == 0u) { if (xb_ld(&(bar)[XB_TMO])) break; if (_sp > XB_SPIN_CAP) { atomicAdd(&(bar)[XB_TMO], 1u); break; } } } } while (0)
struct XcdBarrier { unsigned* bar; unsigned x; volatile LAS unsigned* st; };
__device__ __forceinline__ XcdBarrier xcd_barrier_post(unsigned* bar, volatile LAS unsigned* st) {
    XcdBarrier b; b.bar = bar; b.x = xb_xcc_id(); b.st = st;
    if (threadIdx.x == 0) (void)xb_add(&bar[XB_XCNT(b.x)], 1u);
    return b;
}
__device__ __forceinline__ void xcd_barrier_complete(unsigned* bar, unsigned x, unsigned& nloc, unsigned& nx) {
    const unsigned G = gridDim.x * gridDim.y * gridDim.z;
    unsigned sum, cnt, mine, sp = 0u;
    for (;;) {
        sum = 0u; cnt = 0u; mine = 0u;
#pragma unroll
        for (unsigned j = 0; j < 16; ++j) { const unsigned c = xb_ld(&bar[XB_XCNT(j)]); sum += c; cnt += (c > 0u) ? 1u : 0u; mine = (j == x) ? c : mine; }
        if (sum == G) break;
        __builtin_amdgcn_s_sleep(1);
        if ((++sp & 255u) == 0u) { if (xb_ld(&bar[XB_TMO])) break; if (sp > XB_SPIN_CAP) { atomicAdd(&bar[XB_TMO], 1u); break; } }
    }
    nloc = mine > 0u ? mine : 1u; nx = cnt > 0u ? cnt : 1u;
}
__device__ __forceinline__ void xcd_barrier(const XcdBarrier& b) {
    asm volatile("s_waitcnt vmcnt(0)" ::: "memory");
    __syncthreads();
    if (threadIdx.x == 0) {
        unsigned* bar = b.bar;
        __builtin_amdgcn_s_waitcnt(0);
        unsigned nloc = b.st[0], nx = b.st[1];
        if (nloc == 0u) { xcd_barrier_complete(bar, b.x, nloc, nx); b.st[0] = nloc; b.st[1] = nx; }
        const unsigned old = xb_add(&bar[XB_XSUB(b.x)], 1u);
        const unsigned gen = old / nloc;
        if (old + 1u == (gen + 1u) * nloc) {
            __builtin_amdgcn_fence(__ATOMIC_RELEASE, "agent");
            asm volatile("s_waitcnt vmcnt(0)" ::: "memory");
            const unsigned og = xb_add(&bar[XB_TOP], 1u);
            const unsigned tg = og / nx;
            if (og + 1u == (tg + 1u) * nx) xb_add(&bar[XB_TOPGEN], 1u);
            else XB_SPIN(xb_ld(&bar[XB_TOPGEN]) == tg, bar);
            __builtin_amdgcn_fence(__ATOMIC_ACQUIRE, "agent");
            xb_add(&bar[XB_XGEN(b.x)], 1u);
            asm volatile("s_waitcnt vmcnt(0)" ::: "memory");
        } else {
            XB_SPIN(xb_ld(&bar[XB_XGEN(b.x)]) == gen, bar);
            __builtin_amdgcn_fence(__ATOMIC_ACQUIRE, "agent");
            asm volatile("s_waitcnt vmcnt(0)" ::: "memory");
        }
    }
    __syncthreads();
}

struct Params { const float* in[34]; float* out; unsigned char* ws; int ph_lo, ph_hi; };
enum { I_X = 0, I_C, I_CTX, I_CCTX, I_WADA, I_BADA, I_WIN, I_BIN, I_ALNG, I_ALNB, I_AWS, I_ABS, I_BWDW, I_BBDW, I_BLNG, I_BLNB, I_DQG, I_DWUQ, I_DKVG, I_DWUK, I_DWUV,
       I_WBR, I_WO, I_LN1G, I_LN1B, I_RWG, I_RBG, I_RWE, I_RBE, I_EW1, I_EW3, I_EW2, I_LN2G, I_LN2B };

template <class DestF>
__device__ __forceinline__ void transpose_item(const float* __restrict__ W, int ldw, int k0, int n0, bf16_t* __restrict__ WT, int ldt, int kofs, const float* __restrict__ kscale, DestF dest, LAS float* scr, int lane) {
#pragma unroll 8
    for (int i = 0; i < 32; ++i) { const int kk = 2 * i + (lane >> 5); float v = W[(size_t)(k0 + kk) * ldw + n0 + (lane & 31)]; if (kscale) v *= kscale[k0 + kk]; scr[kk * 33 + (lane & 31)] = v; }
    LDS_WAIT();
    const int c = lane & 7;
#pragma unroll
    for (int j = 0; j < 4; ++j) { const int n = (lane >> 3) + 8 * j; const LAS float* s = scr + (8 * c) * 33 + n;
        u32x4 o; o.x = cvt_pk_bf16(s[0 * 33], s[1 * 33]); o.y = cvt_pk_bf16(s[2 * 33], s[3 * 33]); o.z = cvt_pk_bf16(s[4 * 33], s[5 * 33]); o.w = cvt_pk_bf16(s[6 * 33], s[7 * 33]);
        *(u32x4*)(WT + (size_t)dest(n0 + n) * ldt + kofs + k0 + 8 * c) = o; }
    LDS_WAIT();
}
struct DestId { __device__ int operator()(int n) const { return n; } };
template <class DestF>
__device__ __forceinline__ void transpose8_item(const float* __restrict__ W, int ldw, int k0, int n0, unsigned char* __restrict__ WT8, int ldt, DestF dest, LAS unsigned char* scr8, int lane) {
    const int n = lane & 31, kh = lane >> 5; const float* wp = W + (size_t)(k0 + kh * 64) * ldw + n0 + n;
#pragma unroll
    for (int j = 0; j < 4; ++j) { float v[16];
#pragma unroll
        for (int i = 0; i < 16; ++i) v[i] = wp[(size_t)(j * 16 + i) * ldw] * W8_SCALE;
        u32x4 o; o.x = pk_fp8x4(v[0], v[1], v[2], v[3]); o.y = pk_fp8x4(v[4], v[5], v[6], v[7]); o.z = pk_fp8x4(v[8], v[9], v[10], v[11]); o.w = pk_fp8x4(v[12], v[13], v[14], v[15]);
        *(LAS u32x4*)(scr8 + n * 144 + kh * 64 + j * 16) = o; }
    LDS_WAIT();
#pragma unroll
    for (int j = 0; j < 4; ++j) { const int row = (lane >> 3) + 8 * j, seg = lane & 7;
        *(u32x4*)(WT8 + (size_t)dest(n0 + row) * ldt + k0 + seg * 16) = *(const LAS u32x4*)(scr8 + row * 144 + seg * 16); }
    LDS_WAIT();
}
struct DestWin { __device__ int operator()(int n) const {
    if (n < 1024) return n;
    if (n < 1536) { const int j = n - 1024; return 1024 + (j >> 7) * 256 + (j & 127); }
    if (n < 2048) { const int j = n - 1536; return 1024 + (j >> 7) * 256 + 128 + (j & 127); }
    if (n < 3328) return n;
    if (n < 3360) return 3328 + ropeperm(n - 3328);
    return n + 224; } };
struct DestUq { __device__ int operator()(int n) const { const int h = n / 96, d = n % 96; return d < 64 ? n : h * 96 + 64 + ropeperm(d - 64); } };
struct DestOff { int off; __device__ int operator()(int n) const { return n + off; } };
struct DestGlu { int off; __device__ int operator()(int n) const { return (n >> 7) * 256 + off + (n & 127); } };

__device__ __forceinline__ float mod_val(const float* __restrict__ MODP, const float* __restrict__ b_ada, int l, int which, int j, int k) {
    float s = b_ada[(size_t)l * 12288 + j * 2048 + k];
#pragma unroll
    for (int sl = 0; sl < NSLAB; ++sl) s += MODP[(((size_t)l * NSLAB + sl) * 2 + which) * 12288 + j * 2048 + k];
    return s;
}

__device__ __forceinline__ void mod_vec(LAS float* dst, const float* __restrict__ MODP, const float* __restrict__ b_ada, int l, int which, int j, float add0, int tid) {
    const int k = tid * 4; f32x4 s = *(const f32x4*)(b_ada + (size_t)l * 12288 + j * 2048 + k) + add0;
    f32x4 p[NSLAB];
#pragma unroll
    for (int sl = 0; sl < NSLAB; ++sl) p[sl] = *(const f32x4*)(MODP + (((size_t)l * NSLAB + sl) * 2 + which) * 12288 + j * 2048 + k);
#pragma unroll
    for (int sl = 0; sl < NSLAB; ++sl) s += p[sl];
    *(LAS f32x4*)(dst + k) = s;
}
__device__ __forceinline__ void mod_vec_fast(LAS float* dst, const float* __restrict__ MODV, int l, int which, int j, float add0, int tid) {
    const int k = tid * 4; *(LAS f32x4*)(dst + k) = *(const f32x4*)(MODV + (size_t)((l * 2 + which) * 6 + j) * 2048 + k) + add0;
}
__device__ __forceinline__ void fft32(float (&re)[32], float (&im)[32]) {
    constexpr float C32[16] = {1.0f, 0.9807852804032304f, 0.9238795325112867f, 0.8314696123025452f, 0.7071067811865476f, 0.5555702330196023f, 0.38268343236508984f, 0.19509032201612833f,
                               0.0f, -0.1950903220161282f, -0.3826834323650897f, -0.555570233019602f, -0.7071067811865475f, -0.8314696123025453f, -0.9238795325112867f, -0.9807852804032304f};
    constexpr float S32[16] = {0.0f, 0.19509032201612825f, 0.3826834323650898f, 0.5555702330196022f, 0.7071067811865476f, 0.8314696123025452f, 0.9238795325112867f, 0.9807852804032304f,
                               1.0f, 0.9807852804032304f, 0.9238795325112867f, 0.8314696123025455f, 0.7071067811865476f, 0.5555702330196022f, 0.3826834323650899f, 0.1950903220161286f};
#pragma unroll
    for (int s = 1; s <= 5; ++s) { const int m = 1 << s, h = m >> 1, step = 32 / m;
#pragma unroll
        for (int k = 0; k < 32; k += m)
#pragma unroll
            for (int j = 0; j < h; ++j) { const float c = C32[j * step], sn = S32[j * step]; const int a = k + j, b = k + j + h;
                const float tr = re[b] * c + im[b] * sn, ti = im[b] * c - re[b] * sn;
                re[b] = re[a] - tr; im[b] = im[a] - ti; re[a] += tr; im[a] += ti; } }
}
__host__ __device__ constexpr int brev5(int i) { return ((i & 1) << 4) | ((i & 2) << 2) | (i & 4) | ((i & 8) >> 2) | ((i & 16) >> 4); }
__device__ __forceinline__ void row_stats(const f32x4 (&v)[8], float& mean, float& rstd) {
    float s = 0.f;
#pragma unroll
    for (int j = 0; j < 8; ++j) s += (v[j][0] + v[j][1]) + (v[j][2] + v[j][3]);
    mean = wave_sum(s) * (1.0f / 2048.0f); float q = 0.f;
#pragma unroll
    for (int j = 0; j < 8; ++j) { const f32x4 d = v[j] - mean; q += (d[0] * d[0] + d[1] * d[1]) + (d[2] * d[2] + d[3] * d[3]); }
    rstd = 1.0f / sqrtf(wave_sum(q) * (1.0f / 2048.0f) + LN_EPS);
}

__device__ __forceinline__ void block_stats(const f32x4 v, LAS float* rs, int wave, float& mean, float& rstd) {
    const float s = wave_sum((v[0] + v[1]) + (v[2] + v[3])); rs[wave] = s; __syncthreads();
    float t = 0.f;
#pragma unroll
    for (int w = 0; w < 8; ++w) t += rs[w];
    mean = t * (1.0f / 2048.0f); const f32x4 d = v - mean;
    const float q = wave_sum((d[0] * d[0] + d[1] * d[1]) + (d[2] * d[2] + d[3] * d[3])); rs[8 + wave] = q; __syncthreads();
    t = 0.f;
#pragma unroll
    for (int w = 0; w < 8; ++w) t += rs[8 + w];
    rstd = 1.0f / sqrtf(t * (1.0f / 2048.0f) + LN_EPS);
}
__device__ __forceinline__ void route_pick(const float (&lgt)[36], const float* rbg, const float* rbe, int tok, int* TOKE, float* TOKG) {
    float gl[4];
#pragma unroll
    for (int c = 0; c < 4; ++c) gl[c] = lgt[c] + rbg[c];
    int gi = 0; float gm = gl[0];
#pragma unroll
    for (int c = 1; c < 4; ++c) if (gl[c] > gm) { gm = gl[c]; gi = c; }
    float gs = 0.f;
#pragma unroll
    for (int c = 0; c < 4; ++c) gs += expf(gl[c] - gm);
    const float gp = 1.0f / gs;
    float el[8];
#pragma unroll
    for (int c = 0; c < 8; ++c) { float v = 0.f;
#pragma unroll
        for (int g2 = 0; g2 < 4; ++g2) v = (gi == g2) ? lgt[4 + g2 * 8 + c] : v;
        el[c] = v + rbe[gi * 8 + c]; }
    int i0 = 0; float v0 = el[0];
#pragma unroll
    for (int c = 1; c < 8; ++c) if (el[c] > v0) { v0 = el[c]; i0 = c; }
    int i1 = -1; float v1 = -3.0e38f;
#pragma unroll
    for (int c = 0; c < 8; ++c) if (c != i0 && el[c] > v1) { v1 = el[c]; i1 = c; }
    const float e1 = expf(v1 - v0), p0 = 1.0f / (1.0f + e1), p1 = e1 / (1.0f + e1);
    TOKE[tok * 2] = gi * 8 + i0; TOKE[tok * 2 + 1] = gi * 8 + i1; TOKG[tok * 2] = p0 * gp; TOKG[tok * 2 + 1] = p1 * gp;
}

typedef const __attribute__((address_space(4))) Params* CP;
__device__ __forceinline__ CP kparams() { CP p = (CP)__builtin_amdgcn_kernarg_segment_ptr(); asm volatile("" : "+s"(p)); return p; }
#define WSP(T, off) ((T*)(ws + (off)))
__device__ __forceinline__ int launder_s(int x) { asm volatile("" : "+s"(x)); return x; }
#define PHASE_IDS const int tid = launder((int)threadIdx.x), lane = tid & 63, wave = __builtin_amdgcn_readfirstlane(tid >> 6); const int bx = launder_s((int)blockIdx.x), G = launder_s((int)gridDim.x), gw = bx * 8 + wave, NGW = G * 8; (void)lane; (void)gw; (void)NGW; (void)wave
#ifndef PH_MASK
#define PH_MASK 0xFFFFFFFFu
#endif
#define IN(k) (lo <= (k) && (k) < hi)
#define SEL(j) (((PH_MASK) >> (j)) & 1u)
#define SEAM(k) do { if (IN(k) && IN((k) + 1)) xcd_barrier(bar); } while (0)
template <int l>
__device__ __forceinline__ void layer_phases(const int lo, const int hi, const XcdBarrier& bar, LAS unsigned char* lds) {
        const int pb = 2 + 11 * l; const bool lastl = (l == 1);
        const int rowbeg = lastl ? CTX : 0;
        if (SEL(0) && IN(pb + 0)) {
            PHASE_IDS;
            CP Pp = kparams(); unsigned char* ws = Pp->ws;
            pg8::Gemm g{WSP(bf16_t, WS_HN), WSP(bf16_t, WS_WINT) + (size_t)l * NWIN * 2048, 2048};
            pg8::RectOrder S; S.init(32, 14, 1, G, bx, 0, lastl ? 12 : 0, lastl ? 2 : 14);
            EpiWin E{WSP(float, WS_BINP) + (size_t)l * NWIN, WSP(bf16_t, WS_ZA), WSP(bf16_t, WS_ZB), WSP(bf16_t, WS_ZCT), WSP(bf16_t, WS_ZD), WSP(bf16_t, WS_ZKV), WSP(bf16_t, WS_KF), WSP(bf16_t, WS_GATES), WSP(float, WS_SQD), WSP(float, WS_SQKV)};
            pg8::gemm_phase<EpiWin, pg8::RectOrder, true, true>(lds, g, S, E);
            {
                CP Pp2 = kparams(); unsigned char* ws2 = Pp2->ws;
                pg8::Gemm g8{(const bf16_t*)(ws2 + WS_HN8), (const bf16_t*)(ws2 + WS_WG8 + (size_t)l * 8192 * 2048), 1024};
                pg8::RectOrder S8; S8.init(lastl ? 32 : 33, 32, lastl ? 1 : 0, G, (bx + G - 206) % G);
                EpiGate8 E8{(const float*)(ws2 + WS_BINP) + (size_t)l * NWIN + 3584, ws2 + WS_GATES};
                pg8::gemm_phase<EpiGate8, pg8::RectOrder, true, true, true>(lds, g8, S8, E8);
            }
        }
        SEAM(pb + 0);
        if (SEL(1) && IN(pb + 1)) {
            PHASE_IDS;
            if (SEL(13)) { CP Pp = kparams(); unsigned char* ws = Pp->ws; pg8::Gemm g{WSP(bf16_t, WS_ZD), WSP(bf16_t, WS_WUQT) + (size_t)l * 768 * 512, 512}; pg8::RectOrder S; S.init(lastl ? 32 : 33, 3, lastl ? 1 : 0, G, bx);
              EpiQ E{WSP(float, WS_SQD), WSP(bf16_t, WS_Q)}; pg8::gemm_phase<EpiQ, pg8::RectOrder, true, true>(lds, g, S, E); }
            if (SEL(14)) { CP Pp = kparams(); unsigned char* ws = Pp->ws; pg8::Gemm g{WSP(bf16_t, WS_ZKV), WSP(bf16_t, WS_WUKVT) + (size_t)l * 1024 * 256, 256}; pg8::RectOrder S; S.init(33, 4, 0, G, (bx + G - 99) % G);
              EpiKV E{WSP(float, WS_SQKV), WSP(bf16_t, WS_KF), WSP(bf16_t, WS_V)}; pg8::gemm_phase<EpiKV, pg8::RectOrder, true, true>(lds, g, S, E); }
            __syncthreads();
            CP Pp = kparams(); unsigned char* ws = Pp->ws;
            bf16_t* ZA = WSP(bf16_t, WS_ZA); bf16_t* ZB = WSP(bf16_t, WS_ZB); bf16_t* ZCT = WSP(bf16_t, WS_ZCT); bf16_t* BR = WSP(bf16_t, WS_BR); bf16_t* GT = WSP(bf16_t, WS_GT);
            const int nchunk = lastl ? 64 : 66, chunk0 = lastl ? 2 : 0;
            const int nA = nchunk * 4, nB = lastl ? 256 : 264, nF = 256;
            for (int it = (bx + G - 231) % G; it < nA + nB + nF; it += G) {
                if (SEL(15) && it < nA) {
                    const int chunk = chunk0 + (it >> 2), g = it & 3, r0 = chunk * 128;
                    LAS bf16_t* T = (LAS bf16_t*)lds;
                    const float* lng = Pp->in[I_ALNG] + l * 512, *lnb = Pp->in[I_ALNB] + l * 512;
                    u32x4 rawv[16];
#pragma unroll
                    for (int rr = 0; rr < 16; ++rr) rawv[rr] = *(const u32x4*)(ZA + (size_t)(r0 + wave * 16 + rr) * 1024 + 512 + lane * 8);
#pragma unroll
                    for (int rr = 0; rr < 16; ++rr) { const int q = wave * 16 + rr; const u32x4 raw = rawv[rr];
                        float x[8]; x[0] = bflo(raw.x); x[1] = bfhi(raw.x); x[2] = bflo(raw.y); x[3] = bfhi(raw.y); x[4] = bflo(raw.z); x[5] = bfhi(raw.z); x[6] = bflo(raw.w); x[7] = bfhi(raw.w);
                        float s = 0.f;
#pragma unroll
                        for (int j = 0; j < 8; ++j) s += x[j];
                        const float mean = wave_sum(s) * (1.0f / 512.0f); float qq = 0.f;
#pragma unroll
                        for (int j = 0; j < 8; ++j) { const float d = x[j] - mean; qq += d * d; }
                        const float rstd = 1.0f / sqrtf(wave_sum(qq) * (1.0f / 512.0f) + LN_EPS);
                        if ((lane >> 4) == g) {
#pragma unroll
                            for (int j = 0; j < 8; ++j) { const int ch = lane * 8 + j; T[((lane & 15) * 8 + j) * 136 + q] = (bf16_t)f2bf((x[j] - mean) * rstd * lng[ch] + lnb[ch]); } }
                    }
                    __syncthreads();
                    const int fr = lane & 15, fq = lane >> 4;
                    const float* Wsp = Pp->in[I_AWS] + (((size_t)l * 4 + g) * 128 + wave * 16 + fr) * 128;
                    f32x4 accm[8];
#pragma unroll
                    for (int j = 0; j < 8; ++j) accm[j] = (f32x4){0.f, 0.f, 0.f, 0.f};
#pragma unroll
                    for (int ks = 0; ks < 4; ++ks) { const f32x4 w0 = *(const f32x4*)(Wsp + ks * 32 + fq * 8), w1 = *(const f32x4*)(Wsp + ks * 32 + fq * 8 + 4);
                        const u32x4 aw = pack8(w0, w1); const bf16x8 a = __builtin_bit_cast(bf16x8, aw);
#pragma unroll
                        for (int j = 0; j < 8; ++j) { const bf16x8 b = *(const LAS bf16x8*)(T + (j * 16 + fr) * 136 + ks * 32 + fq * 8);
                            accm[j] = __builtin_amdgcn_mfma_f32_16x16x32_bf16(a, b, accm[j], 0, 0, 0); } }
#pragma unroll
                    for (int i = 0; i < 4; ++i) { const int p = wave * 16 + fq * 4 + i; const float bs = Pp->in[I_ABS][((size_t)l * 4 + g) * 128 + p];
#pragma unroll
                        for (int j = 0; j < 8; ++j) { const int c = g * 128 + j * 16 + fr; const float uu = bf2f(ZA[(size_t)(r0 + p) * 1024 + c]);
                            BR[(size_t)(r0 + p) * KMERGE + c] = (bf16_t)f2bf(uu * (accm[j][i] + bs)); } }
                    __syncthreads();
                } else if (SEL(16) && it >= nA && it < nA + nB) {
                    const int ub = it - nA; int seq0, seqlen, t0;
                    if (lastl) { seq0 = CTX; seqlen = SEQ; t0 = ub * 32; } else if (ub < 8) { seq0 = 0; seqlen = CTX; t0 = ub * 32; } else { seq0 = CTX; seqlen = SEQ; t0 = (ub - 8) * 32; }
                    LAS bf16_t* Yin = (LAS bf16_t*)lds;
                    LAS float* Co = (LAS float*)(lds + 65536);
                    for (int pr = wave; pr < 62; pr += 8) { const int t = t0 - 15 + pr; u32x4 vv = {0u, 0u, 0u, 0u};
                        if (t >= 0 && t < seqlen) vv = *(const u32x4*)(ZB + (size_t)(seq0 + t) * 512 + lane * 8);
                        *(LAS u32x4*)(Yin + pr * 512 + lane * 8) = vv; }
                    __syncthreads();
                    { const int ch = tid; float wv[31];
#pragma unroll
                      for (int j = 0; j < 31; ++j) wv[j] = Pp->in[I_BWDW][((size_t)l * 31 + j) * 512 + ch];
                      const float bb = Pp->in[I_BBDW][l * 512 + ch];
                      float win[31];
#pragma unroll
                      for (int j = 0; j < 30; ++j) win[j + 1] = bf2f(Yin[j * 512 + ch]);
#pragma unroll
                      for (int p = 0; p < 32; ++p) {
#pragma unroll
                          for (int j = 0; j < 30; ++j) win[j] = win[j + 1];
                          win[30] = bf2f(Yin[(p + 30) * 512 + ch]);
                          float a = bb;
#pragma unroll
                          for (int j = 0; j < 31; ++j) a += win[j] * wv[j];
                          Co[p * 512 + ch] = a; } }
                    __syncthreads();
                    for (int pp = 0; pp < 4; ++pp) { const int p = wave * 4 + pp; const f32x4 x0 = *(const LAS f32x4*)(Co + p * 512 + lane * 8), x1 = *(const LAS f32x4*)(Co + p * 512 + lane * 8 + 4);
                        const float s = (x0[0] + x0[1]) + (x0[2] + x0[3]) + (x1[0] + x1[1]) + (x1[2] + x1[3]); const float mean = wave_sum(s) * (1.0f / 512.0f);
                        const f32x4 d0 = x0 - mean, d1 = x1 - mean; const float qq = (d0[0] * d0[0] + d0[1] * d0[1]) + (d0[2] * d0[2] + d0[3] * d0[3]) + (d1[0] * d1[0] + d1[1] * d1[1]) + (d1[2] * d1[2] + d1[3] * d1[3]);
                        const float rstd = 1.0f / sqrtf(wave_sum(qq) * (1.0f / 512.0f) + LN_EPS);
                        const float* lg = Pp->in[I_BLNG] + l * 512 + lane * 8; const float* lb = Pp->in[I_BLNB] + l * 512 + lane * 8;
                        f32x4 y0, y1;
#pragma unroll
                        for (int e = 0; e < 4; ++e) { y0[e] = fsilu(d0[e] * rstd * lg[e] + lb[e]); y1[e] = fsilu(d1[e] * rstd * lg[4 + e] + lb[4 + e]); }
                        *(u32x4*)(BR + (size_t)(seq0 + t0 + p) * KMERGE + 512 + lane * 8) = pack8(y0, y1); }
                    __syncthreads();
                } else if (SEL(17) && it >= nA + nB) {
                    const int uf = it - nA - nB, ch = uf * 2 + (tid >> 8), n1 = tid & 255;
                    const bf16_t* src = ZCT + (size_t)ch * NROW + CTX + n1;
                    float xr[32], xi[32];
#pragma unroll
                    for (int i = 0; i < 32; ++i) { xr[i] = bf2f(src[brev5(i) * 256]); xi[i] = 0.f; }
                    fft32(xr, xi);
#pragma unroll
                    for (int k2 = 0; k2 < 32; ++k2) { const float gr = xr[k2], gi = xi[k2];
                        const float rv = (float)(n1 * k2) * (1.0f / 8192.0f); const float ct = __builtin_amdgcn_cosf(rv), st = __builtin_amdgcn_sinf(rv);
                        const float sc = 0.17677669529663687f;
                        bf16_t* o = GT + (size_t)(k2 * 512 + ch) * 512 + n1;
                        o[0] = (bf16_t)f2bf((gr * ct + gi * st) * sc); o[256] = (bf16_t)f2bf((gi * ct - gr * st) * sc); }
                    if (!lastl) { bf16_t* o = GT + (size_t)(16384 + ch) * 512 + n1; o[0] = ZCT[(size_t)ch * NROW + n1]; o[256] = 0; }
                }
            }
        }
        SEAM(pb + 1);
        if (SEL(2) && IN(pb + 2)) {
            PHASE_IDS;
            CP Pp = kparams(); unsigned char* ws = Pp->ws; bf16_t* QB = WSP(bf16_t, WS_Q); bf16_t* KF = WSP(bf16_t, WS_KF); bf16_t* VB = WSP(bf16_t, WS_V); bf16_t* BR = WSP(bf16_t, WS_BR);
            if (SEL(18)) { const int h = bx & 7, qb = bx >> 3;
              for (int ua = bx; ua < 256; ua += G) { const int hh = ua & 7, qq = ua >> 3; (void)h; (void)qb;
                  attn::attn_unit(QB + (size_t)(CTX + qq * 256) * 768 + hh * 96, KF + hh * 96, VB + hh * 64, BR + (size_t)(CTX + qq * 256) * KMERGE + 2048 + hh * 64, NROW, lds); }
              if (!lastl) for (int ua = bx; ua < 8; ua += G) attn::attn_unit(QB + ua * 96, KF + ua * 96, VB + ua * 64, BR + 2048 + ua * 64, CTX, lds); }
            if (SEL(19)) { CP Pp2 = kparams(); unsigned char* ws = Pp2->ws; pg8::Gemm g{WSP(bf16_t, WS_FMAT), WSP(bf16_t, WS_GT), 512}; pg8::RectOrder S; S.init(2, lastl ? 64 : 66, 0, G, (bx + G - 8) % G);
              EpiF2 E{WSP(bf16_t, WS_BR)}; pg8::gemm_phase<EpiF2, pg8::RectOrder, true, true>(lds, g, S, E); }
        }
        SEAM(pb + 2);
        if (SEL(3) && IN(pb + 3)) {
            PHASE_IDS;
            CP Pp = kparams(); unsigned char* ws = Pp->ws;
            pg8::Gemm g{WSP(bf16_t, WS_BR), WSP(bf16_t, WS_WMT) + (size_t)l * 2048 * KMERGE, KMERGE}; pg8::RectOrder S; S.init(32, 8, 1, G, bx);
            EpiMerge E{WSP(unsigned char, WS_GATES), WSP(bf16_t, WS_Y)}; pg8::gemm_phase<EpiMerge, pg8::RectOrder, true, true>(lds, g, S, E);
            if (!lastl) { CP Pp2 = kparams(); unsigned char* ws2 = Pp2->ws;
                for (int uc = bx; uc < 256; uc += G) ctx_gemm<true>((const bf16_t*)(ws2 + WS_BR), (const bf16_t*)(ws2 + WS_WMT) + (size_t)l * 2048 * KMERGE, uc, (const unsigned char*)(ws2 + WS_GATES), (bf16_t*)(ws2 + WS_Y), nullptr, (LAS float*)lds); }
        }
        SEAM(pb + 3);
        if (SEL(4) && IN(pb + 4)) {
            PHASE_IDS;
            CP Pp = kparams(); unsigned char* ws = Pp->ws;
            pg8::Gemm g{WSP(bf16_t, WS_Y), WSP(bf16_t, WS_WOT) + (size_t)l * 2048 * 2048, 2048}; pg8::RectOrder S; S.init(32, 8, 1, G, bx);
            EpiWo E{WSP(bf16_t, WS_MIX)}; pg8::gemm_phase<EpiWo, pg8::RectOrder, true, true>(lds, g, S, E);
            if (!lastl) { CP Pp2 = kparams(); unsigned char* ws2 = Pp2->ws;
                for (int uc = bx; uc < 256; uc += G) ctx_gemm<false>((const bf16_t*)(ws2 + WS_Y), (const bf16_t*)(ws2 + WS_WOT) + (size_t)l * 2048 * 2048, uc, nullptr, nullptr, (bf16_t*)(ws2 + WS_MIX), (LAS float*)lds); }
        }
        SEAM(pb + 4);
        if (SEL(5) && IN(pb + 5)) {
            PHASE_IDS;
            CP Pp = kparams(); unsigned char* ws = Pp->ws; float* MODP = WSP(float, WS_MODP); bf16_t* MIX = WSP(bf16_t, WS_MIX); float* XA = WSP(float, WS_XA); float* XB = WSP(float, WS_XB); float* H32 = WSP(float, WS_H32); unsigned char* H8 = WSP(unsigned char, WS_H8);
#define PF_LOADX(r, XV) do { const float* xr_ = lastl ? XB + (size_t)(r) * D : ((r) < CTX ? Pp->in[I_CTX] + (size_t)(r) * D : Pp->in[I_X] + (size_t)((r) - CTX) * D); \
    _Pragma("unroll") for (int j = 0; j < 8; ++j) { XV[j] = *(const f32x4*)(xr_ + j * 256 + lane * 4); mv[j] = *(const u32x2*)(MIX + (size_t)(r) * D + j * 256 + lane * 4); } } while (0)
#define PF_XPTR(r) (lastl ? XB + (size_t)(r) * D : ((r) < CTX ? Pp->in[I_CTX] + (size_t)(r) * D : Pp->in[I_X] + (size_t)((r) - CTX) * D))
            const int nblk = (NROW - rowbeg) / 32, blk0 = (G == 256 ? 64 * ((bx & 7) >> 1) + 2 * (bx >> 3) + (bx & 1) : bx) + (lastl ? 0 : CTX / 32); const int r32 = lane & 31, kk = lane >> 5;
            f32x4 xv[8]; u32x2 mv[8]; f32x4 cx = {0.f, 0.f, 0.f, 0.f}; u32x2 cm = {0u, 0u};
            if (blk0 < nblk) PF_LOADX(rowbeg + blk0 * 32 + wave * 4, xv);
            (void)cx; (void)cm;
            LAS float* MS = (LAS float*)lds;
            const float* MODV = WSP(float, WS_H32 + (2u << 20));
            mod_vec_fast(MS + 0 * 2048, MODV, l, 0, 2, 0.f, tid); mod_vec_fast(MS + 1 * 2048, MODV, l, 0, 4, 1.f, tid); mod_vec_fast(MS + 2 * 2048, MODV, l, 0, 3, 0.f, tid);
            const float* lg = Pp->in[I_LN1G] + l * D; const float* lb = Pp->in[I_LN1B] + l * D;
            *(LAS f32x4*)(MS + 3 * 2048 + tid * 4) = *(const f32x4*)(lg + tid * 4); *(LAS f32x4*)(MS + 4 * 2048 + tid * 4) = *(const f32x4*)(lb + tid * 4);
            __syncthreads();
            float* WR2 = WSP(float, WS_WR2); int* TOKE = WSP(int, WS_TOKE); float* TOKG = WSP(float, WS_TOKG);
            LAS float* HL = (LAS float*)(lds + 49152);
#define PF_LOAD(r, XV, MV) do { const float* xr_ = lastl ? XB + (size_t)(r) * D : ((r) < CTX ? Pp->in[I_CTX] + (size_t)(r) * D : Pp->in[I_X] + (size_t)((r) - CTX) * D); \
    _Pragma("unroll") for (int j = 0; j < 8; ++j) { const int c = j * 256 + lane * 4; XV[j] = *(const f32x4*)(xr_ + c); MV[j] = *(const u32x2*)(MIX + (size_t)(r) * D + c); } } while (0)
            for (int blk = blk0; blk < nblk; blk += G) {
                const int r0 = rowbeg + blk * 32 + wave * 4;
                f32x4 hreg[4][8];
                if (blk != blk0) PF_LOADX(r0, xv);
#pragma unroll
                for (int i = 0; i < 4; ++i) { const int row = r0 + i;
                    const LAS float* MSw = MS + launder(lane * 4) - lane * 4;
                    f32x4 v[8];
#pragma unroll
                    for (int j = 0; j < 8; ++j) { const int c = j * 256 + lane * 4; const f32x4 mx = {bflo(mv[j].x), bfhi(mv[j].x), bflo(mv[j].y), bfhi(mv[j].y)};
                        v[j] = ALPHA * xv[j] + *(const LAS f32x4*)(MSw + c) * mx; }
                    if (i < 3) PF_LOADX(row + 1, xv);
                    float mean, rstd; row_stats(v, mean, rstd);
#pragma unroll
                    for (int j = 0; j < 8; ++j) { const int c = j * 256 + lane * 4; v[j] = (v[j] - mean) * rstd * *(const LAS f32x4*)(MSw + 3 * 2048 + c) + *(const LAS f32x4*)(MSw + 4 * 2048 + c); *(f32x4*)(XA + (size_t)row * D + c) = v[j]; }
                    row_stats(v, mean, rstd);
#pragma unroll
                    for (int j = 0; j < 8; ++j) { const int c = j * 256 + lane * 4;
                        const f32x4 h = (v[j] - mean) * rstd * *(const LAS f32x4*)(MSw + 2048 + c) + *(const LAS f32x4*)(MSw + 4096 + c);
                        hreg[i][j] = h; *(unsigned*)(H8 + (size_t)row * D + c) = pk_fp8x4(h[0] * H8_SCALE, h[1] * H8_SCALE, h[2] * H8_SCALE, h[3] * H8_SCALE); }
                    __builtin_amdgcn_sched_barrier(0);
                }
                f32x16 a0 = {}, a1 = {};
                LAS bf16_t* HH = (LAS bf16_t*)HL; LAS bf16_t* HO = HH + 32 * 520;
                const bf16_t* WRH = WSP(bf16_t, WS_H32);
#pragma unroll
                for (int c = 0; c < 4; ++c) {
                    __builtin_amdgcn_sched_barrier(0);
                    const bf16_t* wp = WRH + ((((size_t)l * 128 + c * 32 + wave * 4) * 2) * 64 + launder(lane)) * 16;
                    bf16x8 bw[4][4];
#pragma unroll
                    for (int t = 0; t < 1; ++t) { bw[t][0] = *(const bf16x8*)(wp + (size_t)t * 2048); bw[t][1] = *(const bf16x8*)(wp + (size_t)t * 2048 + 8); bw[t][2] = *(const bf16x8*)(wp + (size_t)t * 2048 + 1024); bw[t][3] = *(const bf16x8*)(wp + (size_t)t * 2048 + 1032); }
#pragma unroll
                    for (int i = 0; i < 4; ++i)
#pragma unroll
                        for (int jj = 0; jj < 2; ++jj) { const f32x4 h4 = hreg[i][2 * c + jj]; u32x2 hw, lw;
                            hw.x = cvt_pk_bf16(h4[0], h4[1]); hw.y = cvt_pk_bf16(h4[2], h4[3]);
                            lw.x = cvt_pk_bf16(h4[0] - bflo(hw.x), h4[1] - bfhi(hw.x)); lw.y = cvt_pk_bf16(h4[2] - bflo(hw.y), h4[3] - bfhi(hw.y));
                            *(LAS u32x2*)(HH + (wave * 4 + i) * 520 + jj * 256 + lane * 4) = hw; *(LAS u32x2*)(HO + (wave * 4 + i) * 520 + jj * 256 + lane * 4) = lw; }
                    __syncthreads();
                    const LAS bf16_t* hp = HH + r32 * 520 + wave * 64 + kk * 8;
#pragma unroll
                    for (int t = 1; t < 4; ++t) { bw[t][0] = *(const bf16x8*)(wp + (size_t)t * 2048); bw[t][1] = *(const bf16x8*)(wp + (size_t)t * 2048 + 8); bw[t][2] = *(const bf16x8*)(wp + (size_t)t * 2048 + 1024); bw[t][3] = *(const bf16x8*)(wp + (size_t)t * 2048 + 1032); }
#pragma unroll
                    for (int t = 0; t < 4; ++t) { const bf16x8 ah = *(const LAS bf16x8*)(hp + t * 16), al = *(const LAS bf16x8*)(hp + 32 * 520 + t * 16);
                        a0 = __builtin_amdgcn_mfma_f32_32x32x16_bf16(ah, bw[t][0], a0, 0, 0, 0); a1 = __builtin_amdgcn_mfma_f32_32x32x16_bf16(ah, bw[t][2], a1, 0, 0, 0);
                        a0 = __builtin_amdgcn_mfma_f32_32x32x16_bf16(ah, bw[t][1], a0, 0, 0, 0); a1 = __builtin_amdgcn_mfma_f32_32x32x16_bf16(ah, bw[t][3], a1, 0, 0, 0);
                        a0 = __builtin_amdgcn_mfma_f32_32x32x16_bf16(al, bw[t][0], a0, 0, 0, 0); a1 = __builtin_amdgcn_mfma_f32_32x32x16_bf16(al, bw[t][2], a1, 0, 0, 0); }
                    __syncthreads();
                }
                LAS float* PL = HL;
#pragma unroll
                for (int r = 0; r < 16; ++r) { const int tok = (r & 3) + 8 * (r >> 2) + 4 * kk; PL[(wave * 64 + r32) * 32 + tok] = a0[r]; PL[(wave * 64 + 32 + r32) * 32 + tok] = a1[r]; }
                __syncthreads();
                if (tid < 32) { float lgt[36];
#pragma unroll
                    for (int c = 0; c < 36; ++c) { float s = 0.f;
#pragma unroll
                        for (int w = 0; w < 8; ++w) s += PL[(w * 64 + c) * 32 + tid];
                        lgt[c] = s; if ((c & 3) == 3) __builtin_amdgcn_sched_barrier(0); }
                    route_pick(lgt, Pp->in[I_RBG] + l * 4, Pp->in[I_RBE] + l * 32, blk * 32 + tid, TOKE, TOKG); }
                __syncthreads();
            }
            if (!lastl) {
                CP Pp = kparams(); unsigned char* ws = Pp->ws; bf16_t* MIX = WSP(bf16_t, WS_MIX); float* XA = WSP(float, WS_XA); unsigned char* H8 = WSP(unsigned char, WS_H8); const float* MODV = WSP(float, WS_H32 + (2u << 20));
                const float* lg = Pp->in[I_LN1G] + l * D; const float* lb = Pp->in[I_LN1B] + l * D; float* WR2 = WSP(float, WS_WR2); int* TOKE = WSP(int, WS_TOKE); float* TOKG = WSP(float, WS_TOKG);
                const int tid = launder((int)threadIdx.x), lane = tid & 63, wave = __builtin_amdgcn_readfirstlane(tid >> 6);
                for (int row = bx; row < CTX; row += G) {
                    LAS float* RS = (LAS float*)(lds + 49152); LAS float* hrow = RS + 64; LAS float* PLc = hrow + 2048; const int c = tid * 4;
                    const f32x4 x = *(const f32x4*)(Pp->in[I_CTX] + (size_t)row * D + c); const u32x2 m = *(const u32x2*)(MIX + (size_t)row * D + c);
                    const f32x4 mx = {bflo(m.x), bfhi(m.x), bflo(m.y), bfhi(m.y)};
                    f32x4 v = ALPHA * x + *(const f32x4*)(MODV + (size_t)((l * 2 + 1) * 6 + 2) * 2048 + c) * mx;
                    float mean, rstd; block_stats(v, RS, wave, mean, rstd);
                    v = (v - mean) * rstd * *(const f32x4*)(lg + c) + *(const f32x4*)(lb + c); *(f32x4*)(XA + (size_t)row * D + c) = v;
                    block_stats(v, RS + 16, wave, mean, rstd);
                    const f32x4 h = (v - mean) * rstd * (*(const f32x4*)(MODV + (size_t)((l * 2 + 1) * 6 + 4) * 2048 + c) + 1.0f) + *(const f32x4*)(MODV + (size_t)((l * 2 + 1) * 6 + 3) * 2048 + c);
                    *(unsigned*)(H8 + (size_t)row * D + c) = pk_fp8x4(h[0] * H8_SCALE, h[1] * H8_SCALE, h[2] * H8_SCALE, h[3] * H8_SCALE);
                    *(LAS f32x4*)(hrow + c) = h;
                    __syncthreads();
                    float acc = 0.f; const float* wp = WR2 + ((size_t)l * 256 + wave * 32) * 512 + (lane >> 5) * 128 + (lane & 31) * 4;
#pragma unroll 16
                    for (int q = 0; q < 64; ++q) { const f32x4 hv = *(const LAS f32x4*)(hrow + wave * 256 + q * 4), wv = *(const f32x4*)(wp + (size_t)(q >> 1) * 512 + (q & 1) * 256);
                        acc += (hv[0] * wv[0] + hv[1] * wv[1]) + (hv[2] * wv[2] + hv[3] * wv[3]); }
                    PLc[wave * 64 + lane] = acc;
                    __syncthreads();
                    if (tid < 36) { float s = 0.f;
#pragma unroll
                        for (int w = 0; w < 8; ++w) s += PLc[w * 64 + tid];
                        PLc[512 + tid] = s; }
                    __syncthreads();
                    if (tid == 0) { float lgt[36];
#pragma unroll
                        for (int cc = 0; cc < 36; ++cc) lgt[cc] = PLc[512 + cc];
                        route_pick(lgt, Pp->in[I_RBG] + l * 4, Pp->in[I_RBE] + l * 32, row, TOKE, TOKG); }
                    __syncthreads();
                }
            }
        }
        SEAM(pb + 5);
        if (SEL(7) && IN(pb + 7)) {
            PHASE_IDS;
            CP Pp = kparams(); unsigned char* ws = Pp->ws; unsigned char* H8 = WSP(unsigned char, WS_H8); int* TOKE = WSP(int, WS_TOKE); float* TOKG = WSP(float, WS_TOKG); int* POS = WSP(int, WS_POS);
            float* ROWG = WSP(float, WS_ROWG); int* TILEE = WSP(int, WS_TILEE); int* ROWTOK = WSP(int, WS_XS8);
            const int ntok = NROW - rowbeg, nent = ntok * 2, per = nent / G;
            LAS int* cnt_tot = (LAS int*)lds; LAS int* cnt_bef = cnt_tot + 32; LAS int* pstart = cnt_tot + 64; LAS int* ent_e = cnt_tot + 128; LAS int* ent_d = cnt_tot + 256;
            const int e_lo = bx * per;
            LAS unsigned* hist = (LAS unsigned*)(lds + 2048);
            const int my_e = tid < per ? TOKE[e_lo + tid] : 0; const float my_g = tid < per ? TOKG[e_lo + tid] : 0.f;
            { int ev[33];
#pragma unroll
              for (int q = 0; q < 33; ++q) { const int i = tid + q * 512; ev[q] = i < nent ? TOKE[i] : -1; }
#pragma unroll
              for (int e = 0; e < NEXP; ++e) hist[e * 512 + tid] = 0u;
#pragma unroll
              for (int q = 0; q < 33; ++q) { const int i = tid + q * 512; if (ev[q] >= 0) hist[ev[q] * 512 + tid] += 1u + ((i < e_lo) ? 65536u : 0u); } }
            __syncthreads();
#pragma unroll
            for (int ee = 0; ee < 4; ++ee) { const int e = wave * 4 + ee; unsigned s = 0u;
#pragma unroll
                for (int k = 0; k < 8; ++k) s += hist[e * 512 + k * 64 + lane];
                const float tl = wave_sum((float)(s & 0xffffu)), tb = wave_sum((float)(s >> 16));
                if (lane == 0) { cnt_tot[e] = (int)tl; cnt_bef[e] = (int)tb; } }
            __syncthreads();
            if (tid == 0) { int acc = 0, nt = 0; for (int e = 0; e < NEXP; ++e) { pstart[e] = acc; const int pt = (cnt_tot[e] + 255) >> 8; if (bx == 0) for (int q = 0; q < pt; ++q) TILEE[nt + q] = e | ((q == pt - 1 && cnt_tot[e] - q * 256 <= 128) ? 256 : 0); nt += pt; acc += pt * 256; } if (bx == 0) TILEE[100] = nt; }
            if (tid < per) ent_e[tid] = my_e;
            __syncthreads();
            if (tid < per) { const int e = ent_e[tid]; int rk = cnt_bef[e]; for (int j = 0; j < tid; ++j) rk += (ent_e[j] == e) ? 1 : 0; const int dst = pstart[e] + rk; ent_d[tid] = dst;
                POS[e_lo + tid] = dst; ROWG[dst] = my_g; ROWTOK[dst] = rowbeg + ((e_lo + tid) >> 1); }
            if (bx < NEXP) { const int e = bx, c = cnt_tot[e], pend = pstart[e] + (((c + 255) >> 8) << 8);
                for (int rr = pstart[e] + c + tid; rr < pend; rr += 512) { ROWG[rr] = 0.f; ROWTOK[rr] = rowbeg; } }
            __syncthreads();
        }
        SEAM(pb + 7);
        if (SEL(8) && IN(pb + 8)) {
            PHASE_IDS;
            CP Pp = kparams(); unsigned char* ws = Pp->ws; int* TILEE = WSP(int, WS_TILEE);
            const int vcu = (G % 8 == 0) ? (bx % 8) * (G / 8) + bx / 8 : bx;
            const int nt = TILEE[100];
            pg8::Gemm g{(const bf16_t*)(ws + WS_H8), (const bf16_t*)(ws + WS_W13T8 + (size_t)l * 32 * 2048 * 2048), 1024};
            pg8::MoeGatherOrder S; S.tile_e = TILEE; S.nunits = nt * 8; S.G = G; S.c = vcu; S.rowtok = WSP(int, WS_XS8);
            EpiMoe1F8 E{ws + WS_HS8}; pg8::gemm_phase<EpiMoe1F8, pg8::MoeGatherOrder, true, true, true>(lds, g, S, E);
        }
        SEAM(pb + 8);
        if (SEL(9) && IN(pb + 9)) {
            PHASE_IDS;
            CP Pp = kparams(); unsigned char* ws = Pp->ws; int* TILEE = WSP(int, WS_TILEE);
            const int vcu = (G % 8 == 0) ? (bx % 8) * (G / 8) + bx / 8 : bx;
            const int nt = TILEE[100];
            pg8::Gemm g{(const bf16_t*)(ws + WS_HS8), (const bf16_t*)(ws + WS_W2T8 + (size_t)l * 32 * 2048 * 1024), 512}; pg8::MoeOrder S{TILEE, nt * 8, G, vcu};
            EpiMoe2 E{WSP(float, WS_ROWG), WSP(bf16_t, WS_YR)}; pg8::gemm_phase<EpiMoe2, pg8::MoeOrder, true, true, true>(lds, g, S, E);
        }
        SEAM(pb + 9);
        if (SEL(10) && IN(pb + 10)) {
            PHASE_IDS;
            CP Pp = kparams(); unsigned char* ws = Pp->ws; float* MODP = WSP(float, WS_MODP); float* XA = WSP(float, WS_XA); float* XB = WSP(float, WS_XB); bf16_t* HN = WSP(bf16_t, WS_HN); bf16_t* YR = WSP(bf16_t, WS_YR); int* POS = WSP(int, WS_POS); unsigned char* HN8 = WSP(unsigned char, WS_HN8);
            f32x4 xv[8]; u32x2 av[8], bv[8]; int p0c = 0, p1c = 0, p0n = 0, p1n = 0;
#define PK_LOAD(r, P0, P1, XV, AV, BV) do { const bf16_t* y0_ = YR + (size_t)(P0) * D; const bf16_t* y1_ = YR + (size_t)(P1) * D; \
    _Pragma("unroll") for (int j = 0; j < 8; ++j) { const int c = j * 256 + lane * 4; XV[j] = *(const f32x4*)(XA + (size_t)(r) * D + c); AV[j] = *(const u32x2*)(y0_ + c); BV[j] = *(const u32x2*)(y1_ + c); } } while (0)
            { const int r0_ = rowbeg + gw; if (r0_ < NROW) { p0c = POS[(r0_ - rowbeg) * 2]; p1c = POS[(r0_ - rowbeg) * 2 + 1]; }
              if (r0_ + NGW < NROW) { p0n = POS[(r0_ + NGW - rowbeg) * 2]; p1n = POS[(r0_ + NGW - rowbeg) * 2 + 1]; }
              if (r0_ < NROW) PK_LOAD(r0_, p0c, p1c, xv, av, bv); }
            LAS float* MS = (LAS float*)lds;
#pragma unroll
            for (int which = 0; which < 2; ++which) { mod_vec_fast(MS + (which * 3 + 0) * 2048, WSP(float, WS_H32 + (2u << 20)), l, which, 5, 0.f, tid);
                if (!lastl) { mod_vec_fast(MS + (which * 3 + 1) * 2048, WSP(float, WS_H32 + (2u << 20)), 1, which, 1, 1.f, tid); mod_vec_fast(MS + (which * 3 + 2) * 2048, WSP(float, WS_H32 + (2u << 20)), 1, which, 0, 0.f, tid); } }
            const float* lg = Pp->in[I_LN2G] + l * D; const float* lb = Pp->in[I_LN2B] + l * D;
            *(LAS f32x4*)(MS + 6 * 2048 + tid * 4) = *(const f32x4*)(lg + tid * 4); *(LAS f32x4*)(MS + 7 * 2048 + tid * 4) = *(const f32x4*)(lb + tid * 4);
            __syncthreads();
            for (int row = rowbeg + gw; row < NROW; row += NGW) {
                const int which = row < CTX ? 1 : 0;
                int p0nn = 0, p1nn = 0;
                if (row + 2 * NGW < NROW) { p0nn = POS[(row + 2 * NGW - rowbeg) * 2]; p1nn = POS[(row + 2 * NGW - rowbeg) * 2 + 1]; }
                f32x4 v[8];
#pragma unroll
                for (int j = 0; j < 8; ++j) { const int c = j * 256 + lane * 4; const u32x2 a = av[j], b = bv[j];
                    const f32x4 f = {bflo(a.x) + bflo(b.x), bfhi(a.x) + bfhi(b.x), bflo(a.y) + bflo(b.y), bfhi(a.y) + bfhi(b.y)};
                    v[j] = ALPHA * xv[j] + *(const LAS f32x4*)(MS + (which * 3) * 2048 + c) * f; }
                if (row + NGW < NROW) PK_LOAD(row + NGW, p0n, p1n, xv, av, bv);
                p0n = p0nn; p1n = p1nn;
                float mean, rstd; row_stats(v, mean, rstd);
                float* orow = lastl ? Pp->out + (size_t)(row - CTX) * D : XB + (size_t)row * D;
#pragma unroll
                for (int j = 0; j < 8; ++j) { const int c = j * 256 + lane * 4; v[j] = (v[j] - mean) * rstd * *(const LAS f32x4*)(MS + 6 * 2048 + c) + *(const LAS f32x4*)(MS + 7 * 2048 + c); *(f32x4*)(orow + c) = v[j]; }
                if (!lastl) { row_stats(v, mean, rstd);
#pragma unroll
                    for (int j = 0; j < 8; ++j) { const int c = j * 256 + lane * 4;
                        const f32x4 h = (v[j] - mean) * rstd * *(const LAS f32x4*)(MS + (which * 3 + 1) * 2048 + c) + *(const LAS f32x4*)(MS + (which * 3 + 2) * 2048 + c);
                        u32x2 w; w.x = cvt_pk_bf16(h[0], h[1]); w.y = cvt_pk_bf16(h[2], h[3]); *(u32x2*)(HN + (size_t)row * D + c) = w;
                        *(unsigned*)(HN8 + (size_t)row * D + c) = pk_fp8x4(h[0] * H8_SCALE, h[1] * H8_SCALE, h[2] * H8_SCALE, h[3] * H8_SCALE); } }
            }
        }
        SEAM(pb + 10);
}
__global__ void __launch_bounds__(512, 2) fwd_kernel(Params P_unused) {
    extern __shared__ __attribute__((aligned(16))) unsigned char lds_raw[];
    LAS unsigned char* lds = (LAS unsigned char*)lds_raw;
    volatile LAS unsigned* MISC = (volatile LAS unsigned*)(lds + MISC_OFF);
    const int tid = threadIdx.x, lane = tid & 63, wave = __builtin_amdgcn_readfirstlane(tid >> 6);
    const int G = gridDim.x, bx = blockIdx.x;
    const int gw = bx * 8 + wave, NGW = G * 8;
    int lo, hi; unsigned* barw;
    { CP Pp = kparams(); lo = Pp->ph_lo; hi = Pp->ph_hi; barw = (unsigned*)(Pp->ws + WS_CTL) + CW_BAR; }
    for (int u = tid; u < (LDS_BYTES - RING_BYTES) / 4; u += 512) ((LAS unsigned*)(lds + RING_BYTES))[u] = 0u;
    __syncthreads();
    XcdBarrier bar; bar.bar = barw; bar.x = 0; bar.st = nullptr;
    if (hi - lo > 1) bar = xcd_barrier_post(barw, MISC + 8);

    if (SEL(11) && IN(0)) {
            PHASE_IDS;
        CP Pp = kparams(); unsigned char* ws = Pp->ws;
        float* MODP = WSP(float, WS_MODP); bf16_t* WINT = WSP(bf16_t, WS_WINT); float* BINP = WSP(float, WS_BINP); bf16_t* WMT = WSP(bf16_t, WS_WMT); bf16_t* WOT = WSP(bf16_t, WS_WOT);
        bf16_t* WUQT = WSP(bf16_t, WS_WUQT); bf16_t* WUKVT = WSP(bf16_t, WS_WUKVT); float* WR2 = WSP(float, WS_WR2); bf16_t* FMAT = WSP(bf16_t, WS_FMAT); unsigned char* WG8 = WSP(unsigned char, WS_WG8); unsigned char* W13T8 = WSP(unsigned char, WS_W13T8); unsigned char* W2T8 = WSP(unsigned char, WS_W2T8);
        LAS float* scr = (LAS float*)(lds + wave * 16384); LAS unsigned char* scr8 = lds + wave * 16384 + 8704;
        constexpr int N_GEMV = 2 * NSLAB * 48;
        constexpr int N_WIN = 2 * 32 * 105, N_WG8 = 2 * 16 * 256, N_BRW = 2 * 3 * 8 * 64, N_WC = 2 * 4 * 2 * 4 * 32, N_WO = 2 * 32 * 64, N_UQ = 2 * 8 * 24, N_UKV = 2 * 2 * 4 * 16;
        constexpr int N_W1 = 2 * 32 * 16 * 32, N_W2 = 2 * 32 * 8 * 64, N_FM = 512, N_BIN = 2 * 46, N_WR = 2 * 256, N_ZP = 2 * 224;
        constexpr int NITEMS = N_GEMV + N_WIN + N_WG8 + N_BRW + N_WC + N_WO + N_UQ + N_UKV + 2 * N_W1 + N_W2 + N_FM + N_BIN + N_WR + N_ZP;
        for (int it = gw; it < NITEMS; it += NGW) {
            int r = it;
            if (r < N_GEMV) {
                const int l = r / (NSLAB * 48), sl = (r / 48) % NSLAB, cb = r % 48;
                const float* W = Pp->in[I_WADA] + (size_t)l * 2048 * 12288 + (size_t)(sl * 128) * 12288 + cb * 256 + lane * 4;
                const float c0 = Pp->in[I_C][sl * 128 + lane], c1 = Pp->in[I_C][sl * 128 + 64 + lane], x0 = Pp->in[I_CCTX][sl * 128 + lane], x1 = Pp->in[I_CCTX][sl * 128 + 64 + lane];
                const float sl0 = fsilu(c0), sl1 = fsilu(c1), sx0 = fsilu(x0), sx1 = fsilu(x1);
                f32x4 al = {0.f, 0.f, 0.f, 0.f}, ac = {0.f, 0.f, 0.f, 0.f};
#pragma unroll 8
                for (int k = 0; k < 64; ++k) { const f32x4 w = *(const f32x4*)(W + (size_t)k * 12288); al += w * __shfl(sl0, k); ac += w * __shfl(sx0, k); }
#pragma unroll 8
                for (int k = 0; k < 64; ++k) { const f32x4 w = *(const f32x4*)(W + (size_t)(64 + k) * 12288); al += w * __shfl(sl1, k); ac += w * __shfl(sx1, k); }
                float* o = MODP + (((size_t)l * NSLAB + sl) * 2) * 12288 + cb * 256 + lane * 4;
                *(f32x4*)o = al; *(f32x4*)(o + 12288) = ac; continue; }
            r -= N_GEMV;
            if (r < N_WIN) { const int l = r / (32 * 105), q = r % (32 * 105), kb = q / 105, nb = q % 105;
                transpose_item(Pp->in[I_WIN] + (size_t)l * 2048 * DIN, DIN, kb * 64, nb * 32, WINT + (size_t)l * NWIN * 2048, 2048, 0, nullptr, DestWin(), scr, lane); continue; }
            r -= N_WIN;
            if (r < N_WG8) { const int l = r / (16 * 256), q = r % (16 * 256);
                transpose8_item(Pp->in[I_WIN] + (size_t)l * 2048 * DIN + 3360, DIN, (q / 256) * 128, (q % 256) * 32, WG8 + (size_t)l * 8192 * 2048, 2048, DestId(), scr8, lane); continue; }
            r -= N_WG8;
            if (r < N_BRW) { const int l = r / 1536, q = r % 1536, bi = q / 512, q2 = q % 512, kb = q2 / 64, nb = q2 % 64; const int br = bi == 2 ? 3 : bi;
                transpose_item(Pp->in[I_WBR] + ((size_t)l * 4 + br) * 512 * 2048, 2048, kb * 64, nb * 32, WMT + (size_t)l * 2048 * KMERGE, KMERGE, br == 3 ? 2048 : br * 512, nullptr, DestId(), scr, lane); continue; }
            r -= N_BRW;
            if (r < N_WC) {
                const int l = r / 1024, q = r % 1024, g = q / 256, part = (q / 128) & 1, cblk = (q / 32) & 3, nb = q % 32; const int n = nb * 64 + lane;
                const float* W = Pp->in[I_WBR] + ((size_t)l * 4 + 2) * 512 * 2048 + (size_t)(g * 128) * 2048 + n;
                float a[32];
#pragma unroll
                for (int c = 0; c < 32; ++c) a[c] = 0.f;
                for (int m = 0; m < 128; ++m) { const float w = W[(size_t)m * 2048];
#pragma unroll
                    for (int c = 0; c < 32; ++c) { const float rev = (float)(((cblk * 32 + c) * m) & 127) * (1.0f / 128.0f);
                        const float tv = part ? -__builtin_amdgcn_sinf(rev) : __builtin_amdgcn_cosf(rev); a[c] += tv * w; } }
                bf16_t* o = WMT + (size_t)l * 2048 * KMERGE + (size_t)n * KMERGE + 1024 + g * 256 + part * 128 + cblk * 32;
#pragma unroll
                for (int c8 = 0; c8 < 4; ++c8) { u32x4 w; const float sc = 0.08838834764831845f;
                    w.x = cvt_pk_bf16(a[c8 * 8 + 0] * sc, a[c8 * 8 + 1] * sc); w.y = cvt_pk_bf16(a[c8 * 8 + 2] * sc, a[c8 * 8 + 3] * sc);
                    w.z = cvt_pk_bf16(a[c8 * 8 + 4] * sc, a[c8 * 8 + 5] * sc); w.w = cvt_pk_bf16(a[c8 * 8 + 6] * sc, a[c8 * 8 + 7] * sc); *(u32x4*)(o + c8 * 8) = w; }
                continue; }
            r -= N_WC;
            if (r < N_WO) { const int l = r / 2048, q = r % 2048, kb = q / 64, nb = q % 64;
                transpose_item(Pp->in[I_WO] + (size_t)l * 2048 * 2048, 2048, kb * 64, nb * 32, WOT + (size_t)l * 2048 * 2048, 2048, 0, nullptr, DestId(), scr, lane); continue; }
            r -= N_WO;
            if (r < N_UQ) { const int l = r / 192, q = r % 192, kb = q / 24, nb = q % 24;
                transpose_item(Pp->in[I_DWUQ] + (size_t)l * 512 * 768, 768, kb * 64, nb * 32, WUQT + (size_t)l * 768 * 512, 512, 0, Pp->in[I_DQG] + l * 512, DestUq(), scr, lane); continue; }
            r -= N_UQ;
            if (r < N_UKV) { const int l = r / 128, q = r % 128, which = q / 64, q2 = q % 64, kb = q2 / 16, nb = q2 % 16;
                transpose_item(Pp->in[which ? I_DWUV : I_DWUK] + (size_t)l * 256 * 512, 512, kb * 64, nb * 32, WUKVT + (size_t)l * 1024 * 256, 256, 0, Pp->in[I_DKVG] + l * 256, DestOff{which * 512}, scr, lane); continue; }
            r -= N_UKV;
            if (r < 2 * N_W1) { const int which = r / N_W1, q = r % N_W1, le = q / 512, q2 = q % 512, kb = q2 / 32, nb = q2 % 32;
                transpose8_item(Pp->in[which ? I_EW3 : I_EW1] + (size_t)le * 2048 * 1024, 1024, kb * 128, nb * 32, W13T8 + (size_t)le * 2048 * 2048, 2048, DestGlu{which * 128}, scr8, lane); continue; }
            r -= 2 * N_W1;
            if (r < N_W2) { const int le = r / 512, q2 = r % 512, kb = q2 / 64, nb = q2 % 64;
                transpose8_item(Pp->in[I_EW2] + (size_t)le * 1024 * 2048, 2048, kb * 128, nb * 32, W2T8 + (size_t)le * 2048 * 1024, 1024, DestId(), scr8, lane); continue; }
            r -= N_W2;
            if (r < N_FM) {
                const int po = r >> 8, k1 = r & 255;
#pragma unroll
                for (int j = 0; j < 8; ++j) { const int col = j * 64 + lane, pi = col >> 8, n1 = col & 255; const float rev = (float)((k1 * n1) & 255) * (1.0f / 256.0f);
                    const float c = __builtin_amdgcn_cosf(rev), s = __builtin_amdgcn_sinf(rev); const float v = (po == pi) ? (po ? -c : c) : s;
                    FMAT[(size_t)r * 512 + col] = (bf16_t)f2bf(v * 0.0625f); }
                continue; }
            r -= N_FM;
            if (r < N_BIN) { const int l = r / 46, t = r % 46;
#pragma unroll
                for (int j = 0; j < 4; ++j) BINP[(size_t)l * NWIN + t * 256 + j * 64 + lane] = 0.f;
                continue; }
            r -= N_BIN;
            if (r < N_WR) {
                const int l = r / 256, kg = r % 256;
#pragma unroll
                for (int j = 0; j < 8; ++j) { const int idx = j * 64 + lane, kk = idx >> 8, col = (idx >> 2) & 63, s = idx & 3, k = kg * 8 + kk * 4 + s;
                    float v = 0.f; if (col < 4) v = Pp->in[I_RWG][((size_t)l * 2048 + k) * 4 + col]; else if (col < 36) v = Pp->in[I_RWE][((size_t)l * 2048 + k) * 32 + col - 4];
                    WR2[((size_t)l * 256 + kg) * 512 + idx] = v; }
                {
                    const int col = lane; float w8[8];
#pragma unroll
                    for (int e = 0; e < 8; ++e) { const int k = kg * 8 + e; w8[e] = col < 4 ? Pp->in[I_RWG][((size_t)l * 2048 + k) * 4 + col] : (col < 36 ? Pp->in[I_RWE][((size_t)l * 2048 + k) * 32 + col - 4] : 0.f); }
                    u32x4 hi, lo; unsigned hw[4], lw[4];
#pragma unroll
                    for (int e = 0; e < 4; ++e) { hw[e] = cvt_pk_bf16(w8[2 * e], w8[2 * e + 1]); lw[e] = cvt_pk_bf16(w8[2 * e] - bflo(hw[e]), w8[2 * e + 1] - bfhi(hw[e])); }
                    hi.x = hw[0]; hi.y = hw[1]; hi.z = hw[2]; hi.w = hw[3]; lo.x = lw[0]; lo.y = lw[1]; lo.z = lw[2]; lo.w = lw[3];
                    bf16_t* o = WSP(bf16_t, WS_H32) + (((((size_t)l * 128 + (kg >> 1)) * 2 + (col >> 5)) * 64 + (kg & 1) * 32 + (col & 31)) * 2) * 8;
                    *(u32x4*)o = hi; *(u32x4*)(o + 8) = lo; }
                continue; }
            r -= N_WR;
            { const int l = r / 224, row = 3360 + r % 224;
                u32x4* o = (u32x4*)(WINT + (size_t)l * NWIN * 2048 + (size_t)row * 2048);
#pragma unroll
                for (int j = 0; j < 4; ++j) o[j * 64 + lane] = (u32x4){0u, 0u, 0u, 0u}; }
        }
    }
    SEAM(0);
    if (SEL(12) && IN(1)) {
            PHASE_IDS;
        CP Pp = kparams(); unsigned char* ws = Pp->ws; float* MODP = WSP(float, WS_MODP); float* BINP = WSP(float, WS_BINP); bf16_t* HN = WSP(bf16_t, WS_HN); unsigned char* HN8 = WSP(unsigned char, WS_HN8);
        for (int i = bx * 512 + tid; i < 2 * DIN; i += G * 512) { const int l = i / DIN, n = i % DIN; BINP[(size_t)l * NWIN + DestWin()(n)] = Pp->in[I_BIN][i]; }
#define P1_LOAD(r, B) do { const float* xr_ = (r) < CTX ? Pp->in[I_CTX] + (size_t)(r) * D : Pp->in[I_X] + (size_t)((r) - CTX) * D; \
    _Pragma("unroll") for (int j = 0; j < 8; ++j) B[j] = *(const f32x4*)(xr_ + j * 256 + lane * 4); } while (0)
#define P1_PROC(r, B) do { const int which = (r) < CTX ? 1 : 0; const LAS float* MSw = MS + (which * 2) * 2048 + launder(lane * 4) - lane * 4; float mean, rstd; row_stats(B, mean, rstd); \
    _Pragma("unroll") for (int j = 0; j < 8; ++j) { const f32x4 sc = *(const LAS f32x4*)(MSw + j * 256 + lane * 4), sh = *(const LAS f32x4*)(MSw + 2048 + j * 256 + lane * 4); \
        const f32x4 h = (B[j] - mean) * rstd * sc + sh; u32x2 w; w.x = cvt_pk_bf16(h[0], h[1]); w.y = cvt_pk_bf16(h[2], h[3]); \
        *(u32x2*)(HN + (size_t)(r) * D + j * 256 + lane * 4) = w; \
        *(unsigned*)(HN8 + (size_t)(r) * D + j * 256 + lane * 4) = pk_fp8x4(h[0] * H8_SCALE, h[1] * H8_SCALE, h[2] * H8_SCALE, h[3] * H8_SCALE); } } while (0)
        { f32x4 b0[8], b1[8], b2[8];
          if (gw < NROW) P1_LOAD(gw, b0);
          if (gw + NGW < NROW) P1_LOAD(gw + NGW, b1);
        LAS float* MS = (LAS float*)lds;
#pragma unroll
        for (int which = 0; which < 2; ++which) { mod_vec(MS + (which * 2 + 0) * 2048, MODP, Pp->in[I_BADA], 0, which, 1, 1.f, tid); mod_vec(MS + (which * 2 + 1) * 2048, MODP, Pp->in[I_BADA], 0, which, 0, 0.f, tid); }
        for (int idx = bx * 512 + tid; idx < 12288; idx += G * 512) { const int k = (idx & 511) * 4, t = idx >> 9, j = t % 6, which = (t / 6) & 1, l2 = t / 12;
            f32x4 s = *(const f32x4*)(Pp->in[I_BADA] + (size_t)l2 * 12288 + j * 2048 + k);
#pragma unroll
            for (int sl = 0; sl < NSLAB; ++sl) s += *(const f32x4*)(MODP + (((size_t)l2 * NSLAB + sl) * 2 + which) * 12288 + j * 2048 + k);
            *(f32x4*)(WSP(float, WS_H32 + (2u << 20)) + (size_t)((l2 * 2 + which) * 6 + j) * 2048 + k) = s; }
          if (gw + 2 * NGW < NROW) P1_LOAD(gw + 2 * NGW, b2);
        __syncthreads();
          for (int row = gw; row < NROW; row += 3 * NGW) {
              P1_PROC(row, b0); if (row + 3 * NGW < NROW) P1_LOAD(row + 3 * NGW, b0);
              if (row + NGW < NROW) { P1_PROC(row + NGW, b1); if (row + 4 * NGW < NROW) P1_LOAD(row + 4 * NGW, b1); }
              if (row + 2 * NGW < NROW) { P1_PROC(row + 2 * NGW, b2); if (row + 5 * NGW < NROW) P1_LOAD(row + 5 * NGW, b2); } } }
    }
    SEAM(1);

    layer_phases<0>(lo, hi, bar, lds);
    layer_phases<1>(lo, hi, bar, lds);
#undef IN
#undef SEAM
}

extern "C" void kernel_launch(void* const* d_in, const int* in_sizes, int n_in, void* d_out, int out_size, void* d_ws, size_t ws_size, hipStream_t stream) {
    static int grid = 0;
    if (grid == 0) {
        if (n_in != 34 || out_size != SEQ * D || ws_size < WS_END) { fprintf(stderr, "kernel_launch: unexpected shapes: n_in %d out %d ws %zu (need %zu)\n", n_in, out_size, ws_size, (size_t)WS_END); grid = -1; return; }
        if (hipFuncSetAttribute((const void*)fwd_kernel, hipFuncAttributeMaxDynamicSharedMemorySize, LDS_BYTES) != hipSuccess) { fprintf(stderr, "kernel_launch: hipFuncSetAttribute failed\n"); grid = -1; return; }
        int per_cu = 0;
        if (hipOccupancyMaxActiveBlocksPerMultiprocessor(&per_cu, (const void*)fwd_kernel, 512, LDS_BYTES) != hipSuccess || per_cu < 1) fprintf(stderr, "kernel_launch: occupancy query reports %d\n", per_cu);
        (void)hipGetLastError();
        grid = 256;
    }
    if (grid < 0) return;
    (void)hipMemsetAsync((char*)d_ws + WS_CTL + (size_t)CW_BAR * 4, 0, (size_t)XCD_BAR_WORDS * 4, stream);
    Params p{};
    for (int i = 0; i < 34; ++i) p.in[i] = (const float*)d_in[i];
    p.out = (float*)d_out; p.ws = (unsigned char*)d_ws;
#if MK_LAUNCH_PER_PHASE
    for (int k = 0; k < NPHASE; ++k) { p.ph_lo = k; p.ph_hi = k + 1; hipLaunchKernelGGL(fwd_kernel, dim3(grid), dim3(512), LDS_BYTES, stream, p); }
#else
    p.ph_lo = 0; p.ph_hi = NPHASE;
    hipLaunchKernelGGL(fwd_kernel, dim3(grid), dim3(512), LDS_BYTES, stream, p);
#endif
    const hipError_t le = hipPeekAtLastError();
    if (le != hipSuccess) fprintf(stderr, "kernel_launch: launch failed: %s\n", hipGetErrorName(le));
}
```

```cpp
#include <hip/hip_runtime.h>
#include <cstdio>
#include <cstdint>

#define LAS __attribute__((address_space(3)))
#define GAS __attribute__((address_space(1)))
typedef unsigned short bf16_t;
typedef short bf16x8 __attribute__((ext_vector_type(8)));
typedef short s16x4 __attribute__((ext_vector_type(4)));
typedef float f32x2 __attribute__((ext_vector_type(2)));
typedef float f32x4 __attribute__((ext_vector_type(4)));
typedef float f32x16 __attribute__((ext_vector_type(16)));
typedef unsigned u32x4 __attribute__((ext_vector_type(4)));
typedef unsigned u32x2 __attribute__((ext_vector_type(2)));

#ifndef MK_LAUNCH_PER_PHASE
#define MK_LAUNCH_PER_PHASE 0
#endif

constexpr int D = 2048, SEQ = 8192, CTX = 256, NROW = SEQ + CTX;
constexpr int DIN = 11552, NWIN = 46 * 256;
constexpr int NEXP = 32, DEXP = 1024;
constexpr float ALPHA = 1.4142135623730951f, LN_EPS = 1e-6f;
constexpr int KMERGE = 2560;
constexpr int MAXTILES = 98, XSROWS = MAXTILES * 256;
constexpr int NSLAB = 16;
constexpr int NPHASE = 24;

constexpr size_t al256(size_t x) { return (x + 255) / 256 * 256; }
constexpr size_t WS_CTL = 0, CTL_BYTES = 1u << 20;
constexpr size_t WS_MODP = WS_CTL + CTL_BYTES;
constexpr size_t WS_WINT = al256(WS_MODP + (size_t)2 * NSLAB * 2 * 12288 * 4);
constexpr size_t WS_BINP = al256(WS_WINT + (size_t)2 * NWIN * 2048 * 2);
constexpr size_t WS_WMT = al256(WS_BINP + (size_t)2 * NWIN * 4);
constexpr size_t WS_WOT = al256(WS_WMT + (size_t)2 * 2048 * KMERGE * 2);
constexpr size_t WS_WUQT = al256(WS_WOT + (size_t)2 * 2048 * 2048 * 2);
constexpr size_t WS_WUKVT = al256(WS_WUQT + (size_t)2 * 768 * 512 * 2);
constexpr size_t WS_W13T = al256(WS_WUKVT + (size_t)2 * 1024 * 256 * 2);
constexpr size_t WS_W2T = al256(WS_W13T + 256);
constexpr size_t WS_WR2 = al256(WS_W2T + 256);
constexpr size_t WS_FMAT = al256(WS_WR2 + (size_t)2 * 2048 * 64 * 4);
constexpr size_t WS_HN = al256(WS_FMAT + (size_t)512 * 512 * 2);
constexpr size_t WS_ZA = al256(WS_HN + (size_t)NROW * 2048 * 2);
constexpr size_t WS_ZB = al256(WS_ZA + (size_t)NROW * 1024 * 2);
constexpr size_t WS_ZCT = al256(WS_ZB + (size_t)NROW * 512 * 2);
constexpr size_t WS_ZD = al256(WS_ZCT + (size_t)NROW * 512 * 2);
constexpr size_t WS_ZKV = al256(WS_ZD + (size_t)NROW * 512 * 2);
constexpr size_t WS_SQD = al256(WS_ZKV + (size_t)NROW * 256 * 2);
constexpr size_t WS_SQKV = al256(WS_SQD + (size_t)NROW * 8 * 4);
constexpr size_t WS_GATES = al256(WS_SQKV + (size_t)NROW * 4 * 4);
constexpr size_t WS_Q = al256(WS_GATES + (size_t)NROW * 8192 * 2);
constexpr size_t WS_KF = al256(WS_Q + (size_t)NROW * 768 * 2);
constexpr size_t WS_V = al256(WS_KF + (size_t)NROW * 768 * 2);
constexpr size_t WS_GT = al256(WS_V + (size_t)NROW * 512 * 2);
constexpr size_t WS_BR = al256(WS_GT + (size_t)16896 * 512 * 2);
constexpr size_t WS_Y = al256(WS_BR + (size_t)NROW * KMERGE * 2);
constexpr size_t WS_MIX = al256(WS_Y + (size_t)NROW * 2048 * 2);
constexpr size_t WS_XA = al256(WS_MIX + (size_t)NROW * 2048 * 4);
constexpr size_t WS_XB = al256(WS_XA + (size_t)NROW * 2048 * 4);
constexpr size_t WS_H32 = al256(WS_XB + (size_t)NROW * 2048 * 4);
constexpr size_t WS_TOKE = al256(WS_H32 + (size_t)NROW * 2048 * 4);
constexpr size_t WS_TOKG = al256(WS_TOKE + (size_t)NROW * 2 * 4);
constexpr size_t WS_POS = al256(WS_TOKG + (size_t)NROW * 2 * 4);
constexpr size_t WS_ROWG = al256(WS_POS + (size_t)NROW * 2 * 4);
constexpr size_t WS_TILEE = al256(WS_ROWG + (size_t)XSROWS * 4);
constexpr size_t WS_XS = al256(WS_TILEE + 512);
constexpr size_t WS_HS = al256(WS_XS + 256);
constexpr size_t WS_YR = al256(WS_HS + 256);
constexpr size_t WS_HN8 = al256(WS_YR + (size_t)XSROWS * 2048 * 2);
constexpr size_t WS_WG8 = al256(WS_HN8 + (size_t)NROW * 2048);
constexpr size_t WS_W13T8 = al256(WS_WG8 + (size_t)2 * 8192 * 2048);
constexpr size_t WS_W2T8 = al256(WS_W13T8 + (size_t)2 * 32 * 2048 * 2048);
constexpr size_t WS_XS8 = al256(WS_W2T8 + (size_t)2 * 32 * 2048 * 1024);
constexpr size_t WS_HS8 = al256(WS_XS8 + (size_t)XSROWS * 2048);
constexpr size_t WS_H8 = al256(WS_HS8 + (size_t)XSROWS * 1024);
constexpr size_t WS_END = al256(WS_H8 + (size_t)NROW * 2048);
static_assert(WS_END <= (size_t)2147483648u, "d_ws map exceeds 4 x largest tensor");
constexpr int CW_BAR = 4096;

constexpr int RING_BYTES = 131072, MISC_OFF = RING_BYTES + 320, LDS_BYTES = 147456;

#define LDS_WAIT() asm volatile("s_waitcnt lgkmcnt(0)" ::: "memory")
#define VM_WAIT() asm volatile("s_waitcnt vmcnt(0)" ::: "memory")
__device__ __forceinline__ unsigned f2bf(float f) { unsigned u = __builtin_bit_cast(unsigned, f); return (u + 0x7fffu + ((u >> 16) & 1u)) >> 16; }
__device__ __forceinline__ float bf2f(unsigned b) { return __builtin_bit_cast(float, b << 16); }
__device__ __forceinline__ float bflo(unsigned w) { return __builtin_bit_cast(float, w << 16); }
__device__ __forceinline__ float bfhi(unsigned w) { return __builtin_bit_cast(float, w & 0xffff0000u); }
typedef __bf16 bf16x2_t __attribute__((ext_vector_type(2)));
__device__ __forceinline__ unsigned cvt_pk_bf16(float lo, float hi) { const bf16x2_t v = __builtin_convertvector((f32x2){lo, hi}, bf16x2_t); return __builtin_bit_cast(unsigned, v); }
__device__ __forceinline__ unsigned pk_fp8x4(float a, float b, float c, float d) { int r = __builtin_amdgcn_cvt_pk_fp8_f32(a, b, 0, false); r = __builtin_amdgcn_cvt_pk_fp8_f32(c, d, r, true); return (unsigned)r; }
constexpr float H8_SCALE = 4.0f, W8_SCALE = 64.0f, G8_INV = 1.0f / 256.0f, HS8_SCALE = 8.0f, M2_INV = 1.0f / 512.0f;
__device__ __forceinline__ float fsigmoid(float x) { return __builtin_amdgcn_rcpf(1.0f + __builtin_amdgcn_exp2f(-1.4426950408889634f * x)); }
__device__ __forceinline__ float fsilu(float x) { return x * fsigmoid(x); }
__device__ __forceinline__ float fgelu(float x) { return x * fsigmoid(1.5957691216057308f * (x + 0.044715f * x * x * x)); }
__device__ __forceinline__ int launder(int x) { asm volatile("" : "+v"(x)); return x; }
template <int CTRL> __device__ __forceinline__ float dpp_mov(float v) { return __builtin_bit_cast(float, __builtin_amdgcn_update_dpp(0, __builtin_bit_cast(int, v), CTRL, 0xf, 0xf, false)); }
__device__ __forceinline__ float wave_sum(float v) {
    v += dpp_mov<0x121>(v); v += dpp_mov<0x122>(v); v += dpp_mov<0x124>(v); v += dpp_mov<0x128>(v);
    const int iv = __builtin_bit_cast(int, v);
    const float r0 = __builtin_bit_cast(float, __builtin_amdgcn_readlane(iv, 0)), r1 = __builtin_bit_cast(float, __builtin_amdgcn_readlane(iv, 16));
    const float r2 = __builtin_bit_cast(float, __builtin_amdgcn_readlane(iv, 32)), r3 = __builtin_bit_cast(float, __builtin_amdgcn_readlane(iv, 48));
    return (r0 + r1) + (r2 + r3);
}
__device__ __forceinline__ float rope_inv(int i) { return __builtin_amdgcn_exp2f(-1.6609640474436813f * (float)i); }
__host__ __device__ __forceinline__ int ropeperm(int j) { const int qd = j >> 3, i = j & 7; return (qd >> 1) * 16 + (i >> 2) * 8 + (qd & 1) * 4 + (i & 3); }

namespace pg8 {
constexpr int BM = 256, BK = 64, HALF = 128, HTB = HALF * BK * 2, STAGE_BYTES = 8 * HTB, NXCD = 8, WGM = 8;
__host__ __device__ __forceinline__ int lds_byte(int r, int c) { const int st = (r >> 4) * 2 + (c >> 5), rr = r & 15, cc = c & 31, ob = rr * 64 + cc * 2; return st * 1024 + (ob ^ (((ob >> 9) & 1) << 5)); }
__host__ __device__ __forceinline__ void stage_rc(int b, int& R, int& C) { const int st = b / 1024, sb = b % 1024, swz = sb ^ (((sb >> 9) & 1) << 5); R = (st >> 1) * 16 + swz / 64; C = (st & 1) * 32 + (swz % 64) / 2; }
__host__ __device__ __forceinline__ int perm32(int rho) { const int n = rho >> 4, i = rho & 15; return 8 * (i >> 2) + 4 * n + (i & 3); }

struct Unit { int pm, pn, half; };
struct Gemm { const bf16_t* A; const bf16_t* Bt; int K; };

struct RectOrder {
    static constexpr bool GATHER = false;
    __device__ int arow(const Unit&, int) const { return 0; }
    int nM, nN, nwg, G, c, pm0, xpm, xpn0, xn;
    __device__ void init(int nM_, int nN_, int pm0_, int G_, int c_, int xpm_ = 0, int xpn0_ = 0, int xn_ = 0) { nM = nM_; nN = nN_; nwg = nM * nN; G = G_; c = c_; pm0 = pm0_; xpm = xpm_; xpn0 = xpn0_; xn = xn_; }
    __device__ bool next(int i, Unit& u) const {
        long L = (long)i * G + c;
        if (L < nwg) {
            int wgid = (int)L; { const int q = nwg / NXCD, r = nwg % NXCD, xcd = wgid % NXCD, off = wgid / NXCD; wgid = (xcd < r ? xcd * (q + 1) : r * (q + 1) + (xcd - r) * q) + off; }
            const int nig = WGM * nN, gid = wgid / nig, fm = gid * WGM, gsz = (nM - fm) < WGM ? (nM - fm) : WGM;
            u.pm = pm0 + fm + ((wgid % nig) % gsz); u.pn = (wgid % nig) / gsz; u.half = 0; return true;
        }
        L -= nwg;
        if (L < xn) { u.pm = xpm; u.pn = xpn0 + (int)L; u.half = 0; return true; }
        return false;
    }
};
struct MoeOrder {
    static constexpr bool GATHER = false;
    __device__ int arow(const Unit&, int) const { return 0; }
    const int* tile_e; int nunits, G, c;
    __device__ bool next(int i, Unit& u) const {
        if (G == 256) {
            const int T = min(32, (nunits >> 3) - 32 * i); if (T <= 0) return false;
            const int x = c >> 5, s = c & 31, tl = s >> 3, lo = (x * T) >> 3, hi = ((x + 1) * T) >> 3;
            if (tl >= hi - lo) return false;
            u.pm = 32 * i + lo + tl; const int te = tile_e[u.pm]; u.pn = (te & 0xff) * 8 + (s & 7); u.half = te >> 8; return true; }
        const long L = (long)i * G + c; if (L >= nunits) return false;
        u.pm = (int)(L >> 3); const int te = tile_e[u.pm]; u.pn = (te & 0xff) * 8 + (int)(L & 7); u.half = te >> 8; return true;
    }
};

typedef int v8i_t __attribute__((ext_vector_type(8)));
typedef int v4i_t __attribute__((ext_vector_type(4)));
__device__ __forceinline__ v8i_t cat8(bf16x8 lo, bf16x8 hi) { return __builtin_shufflevector(__builtin_bit_cast(v4i_t, lo), __builtin_bit_cast(v4i_t, hi), 0, 1, 2, 3, 4, 5, 6, 7); }
struct MoeGatherOrder : MoeOrder {
    static constexpr bool GATHER = true;
    const int* rowtok;
    __device__ int arow(const Unit& u, int r) const { return rowtok[u.pm * 256 + r]; }
};
template <class Epi, class Sched, bool ALIGN_EPI, bool SP2, bool FP8 = false>
__device__ __forceinline__ void gemm_phase(LAS unsigned char* lds, const Gemm g, const Sched& S, const Epi& E) {
    const int tid = launder((int)threadIdx.x), wid = __builtin_amdgcn_readfirstlane(tid >> 6), lane = tid & 63, wr = wid >> 2, wc = wid & 3, fr = lane & 15, fq = lane >> 4;
    const int K = g.K, nt = K / BK;
    unsigned voffA[2], voffB[2];
#pragma unroll
    for (int i = 0; i < 2; ++i) { int R, C; stage_rc(tid * 16 + i * 8192, R, C); const int Rb = Epi::PERM ? ((R & ~31) + perm32(R & 31)) : R;
        voffA[i] = (unsigned)(R * K + C) * 2u; voffB[i] = (unsigned)(Rb * K + C) * 2u; }
    const size_t kstep = (size_t)(BK * 2);
    const size_t hstep = (size_t)HALF * K * 2;
    const size_t tstep = 2 * hstep;
    const unsigned ldsw = (unsigned)wid * 1024u;
    const int aoff = lds_byte(wr * 64 + fr, fq * 8), boff = lds_byte(wc * 32 + fr, fq * 8);
#define PG8_SA(b, h) (((b) * 2 + (h)) * HTB)
#define PG8_SB(b, h) ((4 + (b) * 2 + (h)) * HTB)
#define PG8_STAGE(bufoff, gbase, voff) do { _Pragma("unroll") for (int _i = 0; _i < 2; ++_i) \
        __builtin_amdgcn_global_load_lds((const unsigned*)((const char*)(gbase) + (voff)[_i]), (LAS unsigned*)(lds + (bufoff) + ldsw + _i * 8192), 16, 0, 0); } while (0)
#define PG8_LDA(dst, b, h) do { _Pragma("unroll") for (int m = 0; m < 4; ++m) _Pragma("unroll") for (int k = 0; k < 2; ++k) dst[m][k] = *(const LAS bf16x8*)(lds + PG8_SA(b, h) + aoff + m * 2048 + k * 1024); } while (0)
#define PG8_LDB(dst, b, h) do { _Pragma("unroll") for (int n = 0; n < 2; ++n) _Pragma("unroll") for (int k = 0; k < 2; ++k) dst[n][k] = *(const LAS bf16x8*)(lds + PG8_SB(b, h) + boff + n * 2048 + k * 1024); } while (0)
#define PG8_MMA(ai, bj, At, Bt) do { __builtin_amdgcn_s_setprio(1); if constexpr (FP8) { asm volatile("s_nop 4" ::: "memory"); _Pragma("unroll") for (int m = 0; m < 4; ++m) _Pragma("unroll") for (int n = 0; n < 2; ++n) \
        { const v8i_t b8_ = cat8(Bt[n][0], Bt[n][1]), a8_ = cat8(At[m][0], At[m][1]); asm volatile("v_mfma_f32_16x16x128_f8f6f4 %0, %1, %2, %0" : "+v"(acc[ai][bj][m][n]) : "v"(b8_), "v"(a8_)); } } else { \
        _Pragma("unroll") for (int m = 0; m < 4; ++m) _Pragma("unroll") for (int n = 0; n < 2; ++n) _Pragma("unroll") for (int k = 0; k < 2; ++k) \
        acc[ai][bj][m][n] = __builtin_amdgcn_mfma_f32_16x16x32_bf16(Bt[n][k], At[m][k], acc[ai][bj][m][n], 0, 0, 0); } __builtin_amdgcn_s_setprio(0); } while (0)
#define PG8_WAIT_V(n) asm volatile("s_waitcnt vmcnt(" #n ")" ::: "memory")
#define PG8_WAIT_L(n) asm volatile("s_waitcnt lgkmcnt(" #n ")" ::: "memory")
#define PG8_BAR __builtin_amdgcn_s_barrier()
#define PG8_SCHED __builtin_amdgcn_sched_barrier(0)
    Unit cur, nxt; int ui = 0;
    if (!S.next(0, cur)) return;
    static_assert(!Sched::GATHER || SP2, "gathered A rows: SP2 loop only");
    unsigned vAc[2][2] = {{0u, 0u}, {0u, 0u}}, vAn[2][2] = {{0u, 0u}, {0u, 0u}};
    int gR[2] = {0, 0}, gC[2] = {0, 0};
    if constexpr (Sched::GATHER) {
#pragma unroll
        for (int i = 0; i < 2; ++i) { stage_rc(tid * 16 + i * 8192, gR[i], gC[i]);
#pragma unroll
            for (int h = 0; h < 2; ++h) vAc[h][i] = (unsigned)(S.arow(cur, h * HALF + gR[i]) * K + gC[i]) * 2u; } }
#define PG8_STGA(bufoff, kptr, h, nx) do { if constexpr (Sched::GATHER) { const bool nx_ = (nx); const unsigned sel_[2] = {nx_ ? vAn[h][0] : vAc[h][0], nx_ ? vAn[h][1] : vAc[h][1]}; PG8_STAGE(bufoff, kptr, sel_); } \
        else { PG8_STAGE(bufoff, (kptr) + (h) * hstep, voffA); } } while (0)
    f32x4 acc[2][2][4][2];
#pragma unroll
    for (int a = 0; a < 2; ++a)
#pragma unroll
        for (int b = 0; b < 2; ++b)
#pragma unroll
            for (int m = 0; m < 4; ++m)
#pragma unroll
                for (int n = 0; n < 2; ++n) acc[a][b][m][n] = (f32x4){0.f, 0.f, 0.f, 0.f};
    bf16x8 At[4][2], B0[2][2], B1[2][2];
    const char* cA = (const char*)g.A + (Sched::GATHER ? (size_t)0 : (size_t)cur.pm * tstep); const char* cB = (const char*)g.Bt + (size_t)cur.pn * tstep;
    if constexpr (SP2) {
        PG8_STAGE(PG8_SB(0, 0), cB, voffB); PG8_STAGE(PG8_SB(0, 1), cB + hstep, voffB); PG8_STGA(PG8_SA(0, 0), cA, 0, false); PG8_STGA(PG8_SA(0, 1), cA, 1, false);
        if (wr == 1) PG8_BAR;
        PG8_WAIT_V(2); PG8_BAR;
        PG8_STAGE(PG8_SB(1, 0), cB + kstep, voffB); PG8_STGA(PG8_SA(1, 0), cA + kstep, 0, false); PG8_STAGE(PG8_SB(1, 1), cB + hstep + kstep, voffB);
        PG8_WAIT_V(6); PG8_BAR;
    } else {
        PG8_STAGE(PG8_SB(0, 0), cB, voffB); PG8_STAGE(PG8_SA(0, 0), cA, voffA); PG8_STAGE(PG8_SB(0, 1), cB + hstep, voffB); PG8_STAGE(PG8_SA(0, 1), cA + hstep, voffA);
        if (wr == 1) PG8_BAR;
        PG8_WAIT_V(4); PG8_BAR;
        PG8_STAGE(PG8_SB(1, 0), cB + kstep, voffB); PG8_STAGE(PG8_SA(1, 0), cA + kstep, voffA); PG8_STAGE(PG8_SB(1, 1), cB + hstep + kstep, voffB);
        PG8_WAIT_V(6); PG8_BAR;
    }
    for (;;) {
        const bool has_next = S.next(ui + 1, nxt);
        if constexpr (Sched::GATHER) { if (has_next) {
#pragma unroll
            for (int i = 0; i < 2; ++i)
#pragma unroll
                for (int h = 0; h < 2; ++h) vAn[h][i] = (unsigned)(S.arow(nxt, h * HALF + gR[i]) * K + gC[i]) * 2u; } }
        const char* nA = has_next ? (const char*)g.A + (Sched::GATHER ? (size_t)0 : (size_t)nxt.pm * tstep) : cA; const char* nB = has_next ? (const char*)g.Bt + (size_t)nxt.pn * tstep : cB;
#pragma nounroll
        for (int t = 0; t < nt; t += 2) {
            const bool last = (t == nt - 2);
            const char* a1 = cA + (size_t)(t + 1) * kstep;
            const char* a2 = last ? nA : cA + (size_t)(t + 2) * kstep; const char* b2 = last ? nB : cB + (size_t)(t + 2) * kstep;
            const char* a3 = a2 + kstep; const char* b3 = b2 + kstep;
            if constexpr (Epi::MID) { if (t == 8 || t == 16 || t == 32) E.mid(acc, cur, t, wr, wc, fr, fq); }
            if constexpr (SP2) {
            const bool nxu = last && has_next;
            PG8_LDB(B0, 0, 0); PG8_LDB(B1, 0, 1); PG8_SCHED; PG8_LDA(At, 0, 0); PG8_STGA(PG8_SA(1, 1), a1, 1, false);
            PG8_WAIT_V(8); PG8_WAIT_L(0); PG8_BAR; PG8_MMA(0, 0, At, B0); PG8_MMA(0, 1, At, B1); PG8_BAR; PG8_SCHED;
            if (!cur.half) PG8_LDA(At, 0, 1); PG8_STAGE(PG8_SB(0, 0), b2, voffB); PG8_STAGE(PG8_SB(0, 1), b2 + hstep, voffB); PG8_STGA(PG8_SA(0, 0), a2, 0, nxu);
            PG8_WAIT_V(8); PG8_WAIT_L(0); PG8_BAR; if (!cur.half) { PG8_MMA(1, 0, At, B0); PG8_MMA(1, 1, At, B1); } PG8_BAR; PG8_SCHED;
            PG8_LDB(B0, 1, 0); PG8_LDB(B1, 1, 1); PG8_SCHED; PG8_LDA(At, 1, 0); PG8_STGA(PG8_SA(0, 1), a2, 1, nxu);
            PG8_WAIT_V(8); PG8_WAIT_L(0); PG8_BAR; PG8_MMA(0, 0, At, B0); PG8_MMA(0, 1, At, B1); PG8_BAR; PG8_SCHED;
            if (!cur.half) PG8_LDA(At, 1, 1); PG8_STAGE(PG8_SB(1, 0), b3, voffB); PG8_STAGE(PG8_SB(1, 1), b3 + hstep, voffB); PG8_STGA(PG8_SA(1, 0), a3, 0, nxu);
            PG8_WAIT_V(8); PG8_WAIT_L(0); PG8_BAR; if (!cur.half) { PG8_MMA(1, 0, At, B0); PG8_MMA(1, 1, At, B1); } PG8_BAR; PG8_SCHED;
            } else {
            PG8_LDB(B0, 0, 0); PG8_SCHED; PG8_LDA(At, 0, 0); PG8_STAGE(PG8_SA(1, 1), a1 + hstep, voffA);
            PG8_WAIT_L(8); PG8_BAR; PG8_WAIT_L(0); PG8_MMA(0, 0, At, B0); PG8_BAR; PG8_SCHED;
            PG8_LDB(B1, 0, 1); PG8_STAGE(PG8_SB(0, 0), b2, voffB);
            PG8_BAR; PG8_WAIT_L(0); PG8_MMA(0, 1, At, B1); PG8_BAR;
            PG8_LDA(At, 0, 1); PG8_STAGE(PG8_SA(0, 0), a2, voffA);
            PG8_BAR; PG8_WAIT_L(0); PG8_MMA(1, 0, At, B0); PG8_BAR; PG8_SCHED;
            PG8_STAGE(PG8_SB(0, 1), b2 + hstep, voffB);
            PG8_WAIT_V(6); PG8_BAR; PG8_MMA(1, 1, At, B1); PG8_BAR;
            PG8_LDB(B0, 1, 0); PG8_SCHED; PG8_LDA(At, 1, 0); PG8_STAGE(PG8_SA(0, 1), a2 + hstep, voffA);
            PG8_WAIT_L(8); PG8_BAR; PG8_WAIT_L(0); PG8_MMA(0, 0, At, B0); PG8_BAR; PG8_SCHED;
            PG8_LDB(B1, 1, 1); PG8_STAGE(PG8_SB(1, 0), b3, voffB);
            PG8_BAR; PG8_WAIT_L(0); PG8_MMA(0, 1, At, B1); PG8_BAR;
            PG8_LDA(At, 1, 1); PG8_STAGE(PG8_SA(1, 0), a3, voffA);
            PG8_BAR; PG8_WAIT_L(0); PG8_MMA(1, 0, At, B0); PG8_BAR; PG8_SCHED;
            PG8_STAGE(PG8_SB(1, 1), b3 + hstep, voffB);
            PG8_WAIT_V(6); PG8_BAR; PG8_MMA(1, 1, At, B1); PG8_BAR;
            }
        }
        if constexpr (ALIGN_EPI) { if (wr == 0) PG8_BAR; }
        if constexpr (FP8) asm volatile("s_nop 15\n\ts_nop 15" ::: "memory");
        E(acc, cur, wr, wc, fr, fq);
        if (!has_next) break;
#pragma unroll
        for (int a = 0; a < 2; ++a)
#pragma unroll
            for (int b = 0; b < 2; ++b)
#pragma unroll
                for (int m = 0; m < 4; ++m)
#pragma unroll
                    for (int n = 0; n < 2; ++n) acc[a][b][m][n] = (f32x4){0.f, 0.f, 0.f, 0.f};
        cur = nxt; cA = nA; cB = nB; ++ui;
        if constexpr (Sched::GATHER) {
#pragma unroll
            for (int i = 0; i < 2; ++i)
#pragma unroll
                for (int h = 0; h < 2; ++h) vAc[h][i] = vAn[h][i]; }
        if constexpr (ALIGN_EPI) { if (wr == 1) PG8_BAR; }
    }
    PG8_WAIT_V(0);
    if constexpr (!ALIGN_EPI) { if (wr == 0) PG8_BAR; }
    PG8_BAR;
#undef PG8_STGA
#undef PG8_SA
#undef PG8_SB
#undef PG8_STAGE
#undef PG8_LDA
#undef PG8_LDB
#undef PG8_MMA
#undef PG8_WAIT_V
#undef PG8_WAIT_L
#undef PG8_BAR
#undef PG8_SCHED
}
}

typedef const f32x4 (&AccRef)[2][2][4][2];
__device__ __forceinline__ u32x4 pack8(f32x4 v0, f32x4 v1) { u32x4 w; w.x = cvt_pk_bf16(v0[0], v0[1]); w.y = cvt_pk_bf16(v0[2], v0[3]); w.z = cvt_pk_bf16(v1[0], v1[1]); w.w = cvt_pk_bf16(v1[2], v1[3]); return w; }

__device__ __forceinline__ void rope8(f32x4& va, f32x4& vb, int gi, int prow, int pcol) {
    const int half = gi >> 1, i0 = (gi & 1) * 4; const float pos = (float)(half ? pcol : prow);
#pragma unroll
    for (int e = 0; e < 4; ++e) { const float rev = pos * rope_inv(i0 + e) * 0.15915494309189535f;
        const float c = __builtin_amdgcn_cosf(rev), s = __builtin_amdgcn_sinf(rev); const float a = va[e], b = vb[e]; va[e] = a * c - b * s; vb[e] = b * c + a * s; }
}

struct EpiWin {
    static constexpr bool PERM = true, MID = false;
    const float* bias; bf16_t *ZA, *ZB, *ZCt, *ZD, *ZKV, *KF, *GATES; float *SQD, *SQKV;
    __device__ __forceinline__ void operator()(AccRef acc, const pg8::Unit& u, int wr, int wc, int fr, int fq) const {
        const int pn = u.pn, row0 = launder(u.pm * 256 + wr * 64 + fr), colt = launder(pn * 256 + wc * 32 + 8 * fq);
        if (pn == 13) {
            if (wc == 0) {
                const f32x4 b0 = *(const f32x4*)(bias + colt), b1 = *(const f32x4*)(bias + colt + 4);
#pragma unroll
                for (int ai = 0; ai < 2; ++ai)
#pragma unroll
                    for (int m = 0; m < 4; ++m) { const int row = row0 + ai * 128 + m * 16;
                        f32x4 v0 = acc[ai][0][m][0] + b0, v1 = acc[ai][0][m][1] + b1;
                        if (row >= CTX) { const int t = row - CTX; rope8(v0, v1, fq, t >> 6, t & 63); }
                        const u32x4 w = pack8(v0, v1);
#pragma unroll
                        for (int h = 0; h < 8; ++h) *(u32x4*)(KF + (size_t)row * 768 + h * 96 + 64 + 8 * fq) = w; }
            }
            return;
        }
        f32x4 bv[2][2];
#pragma unroll
        for (int bj = 0; bj < 2; ++bj)
#pragma unroll
            for (int n = 0; n < 2; ++n) bv[bj][n] = *(const f32x4*)(bias + colt + bj * 128 + 4 * n);
        asm volatile("" : "+v"(bv[0][0]), "+v"(bv[0][1]), "+v"(bv[1][0]), "+v"(bv[1][1]));
        if (pn < 4) {
#pragma unroll
            for (int ai = 0; ai < 2; ++ai)
#pragma unroll
                for (int m = 0; m < 4; ++m) { const int row = row0 + ai * 128 + m * 16;
#pragma unroll
                    for (int bj = 0; bj < 2; ++bj) { f32x4 v0 = acc[ai][bj][m][0] + bv[bj][0], v1 = acc[ai][bj][m][1] + bv[bj][1];
#pragma unroll
                        for (int e = 0; e < 4; ++e) { v0[e] = fgelu(v0[e]); v1[e] = fgelu(v1[e]); }
                        *(u32x4*)(ZA + (size_t)row * 1024 + colt + bj * 128) = pack8(v0, v1); } }
        } else if (pn < 8) {
            const int c0 = (pn - 4) * 128 + wc * 32 + 8 * fq;
#pragma unroll
            for (int ai = 0; ai < 2; ++ai)
#pragma unroll
                for (int m = 0; m < 4; ++m) { const int row = row0 + ai * 128 + m * 16;
                    f32x4 v0 = acc[ai][0][m][0] + bv[0][0], v1 = acc[ai][0][m][1] + bv[0][1], g0 = acc[ai][1][m][0] + bv[1][0], g1 = acc[ai][1][m][1] + bv[1][1];
#pragma unroll
                    for (int e = 0; e < 4; ++e) { v0[e] *= fsigmoid(g0[e]); v1[e] *= fsigmoid(g1[e]); }
                    *(u32x4*)(ZB + (size_t)row * 512 + c0) = pack8(v0, v1); }
        } else if (pn < 10) {
#pragma unroll
            for (int ai = 0; ai < 2; ++ai)
#pragma unroll
                for (int m = 0; m < 4; ++m) { const int row = row0 + ai * 128 + m * 16;
#pragma unroll
                    for (int bj = 0; bj < 2; ++bj) { const int ch = colt + bj * 128 - 2048; const f32x4 v0 = acc[ai][bj][m][0] + bv[bj][0], v1 = acc[ai][bj][m][1] + bv[bj][1];
#pragma unroll
                        for (int e = 0; e < 4; ++e) { ZCt[(size_t)(ch + e) * NROW + row] = (bf16_t)f2bf(v0[e]); ZCt[(size_t)(ch + 4 + e) * NROW + row] = (bf16_t)f2bf(v1[e]); } } }
        } else if (pn < 13) {
            const bool isq = pn < 12; bf16_t* dst = isq ? ZD : ZKV; const int ld = isq ? 512 : 256, cb = colt - (isq ? 2560 : 3072);
#pragma unroll
            for (int ai = 0; ai < 2; ++ai)
#pragma unroll
                for (int m = 0; m < 4; ++m) { const int row = row0 + ai * 128 + m * 16; float ss = 0.f;
#pragma unroll
                    for (int bj = 0; bj < 2; ++bj) { const f32x4 v0 = acc[ai][bj][m][0] + bv[bj][0], v1 = acc[ai][bj][m][1] + bv[bj][1];
#pragma unroll
                        for (int e = 0; e < 4; ++e) ss += v0[e] * v0[e] + v1[e] * v1[e];
                        *(u32x4*)(dst + (size_t)row * ld + cb + bj * 128) = pack8(v0, v1); }
                    { auto r16 = __builtin_amdgcn_permlane16_swap(__float_as_uint(ss), __float_as_uint(ss), false, false); ss = __uint_as_float(r16[0]) + __uint_as_float(r16[1]); }
                    { auto r32s = __builtin_amdgcn_permlane32_swap(__float_as_uint(ss), __float_as_uint(ss), false, false); ss = __uint_as_float(r32s[0]) + __uint_as_float(r32s[1]); }
                    if (fq == 0) { if (isq) SQD[(size_t)row * 8 + (pn - 10) * 4 + wc] = ss; else SQKV[(size_t)row * 4 + wc] = ss; } }
        } else {
            const int cb = colt - 3584;
#pragma unroll
            for (int ai = 0; ai < 2; ++ai)
#pragma unroll
                for (int m = 0; m < 4; ++m) { const int row = row0 + ai * 128 + m * 16;
#pragma unroll
                    for (int bj = 0; bj < 2; ++bj) { f32x4 v0 = acc[ai][bj][m][0] + bv[bj][0], v1 = acc[ai][bj][m][1] + bv[bj][1];
#pragma unroll
                        for (int e = 0; e < 4; ++e) { v0[e] = fsigmoid(v0[e]); v1[e] = fsigmoid(v1[e]); }
                        *(u32x4*)(GATES + (size_t)row * 8192 + cb + bj * 128) = pack8(v0, v1); } }
        }
    }
};

__device__ __forceinline__ size_t gate_idx(int gt, int pm, int ai, int m, int bj, int wave, int lane) { return ((((((size_t)(gt * 33 + pm) * 2 + ai) * 4 + m) * 2 + bj) * 8 + wave) * 64 + lane) * 8; }
__device__ __forceinline__ float gate_rc(const unsigned char* G8, int row, int s, int col) {
    const int pm = row >> 8, rr = row & 255, pn = col >> 8, cc = col & 255;
    const size_t i = gate_idx(s * 8 + pn, pm, rr >> 7, (rr >> 4) & 3, cc >> 7, ((rr >> 6) & 1) * 4 + ((cc >> 5) & 3), ((cc >> 3) & 3) * 16 + (rr & 15)) + (cc & 7);
    return __builtin_amdgcn_cvt_f32_fp8((int)G8[i], 0);
}
__device__ __forceinline__ void gate8_unpack(u32x2 g, float (&o)[8]) {
    const f32x2 a = __builtin_amdgcn_cvt_pk_f32_fp8((int)g.x, false), b = __builtin_amdgcn_cvt_pk_f32_fp8((int)g.x, true), c = __builtin_amdgcn_cvt_pk_f32_fp8((int)g.y, false), d = __builtin_amdgcn_cvt_pk_f32_fp8((int)g.y, true);
    o[0] = a.x; o[1] = a.y; o[2] = b.x; o[3] = b.y; o[4] = c.x; o[5] = c.y; o[6] = d.x; o[7] = d.y;
}
struct EpiGate8 {
    static constexpr bool PERM = true, MID = false;
    const float* bias; unsigned char* GATES;
    __device__ __forceinline__ void operator()(AccRef acc, const pg8::Unit& u, int wr, int wc, int fr, int fq) const {
        const int colt = launder(u.pn * 256 + wc * 32 + 8 * fq);
        f32x4 bv[2][2];
#pragma unroll
        for (int bj = 0; bj < 2; ++bj)
#pragma unroll
            for (int n = 0; n < 2; ++n) bv[bj][n] = *(const f32x4*)(bias + colt + bj * 128 + 4 * n);
#pragma unroll
        for (int ai = 0; ai < 2; ++ai)
#pragma unroll
            for (int m = 0; m < 4; ++m) {
#pragma unroll
                for (int bj = 0; bj < 2; ++bj) { f32x4 v0 = acc[ai][bj][m][0] * G8_INV + bv[bj][0], v1 = acc[ai][bj][m][1] * G8_INV + bv[bj][1];
#pragma unroll
                    for (int e = 0; e < 4; ++e) { v0[e] = fmaxf(fsigmoid(v0[e]), 0.00390625f); v1[e] = fmaxf(fsigmoid(v1[e]), 0.00390625f); }
                    u32x2 w; w.x = pk_fp8x4(v0[0], v0[1], v0[2], v0[3]); w.y = pk_fp8x4(v1[0], v1[1], v1[2], v1[3]);
                    *(u32x2*)(GATES + gate_idx(u.pn, u.pm, ai, m, bj, wr * 4 + wc, fq * 16 + fr)) = w; } }
    }
};
struct EpiQ {
    static constexpr bool PERM = true, MID = false;
    const float* SQD; bf16_t* Q;
    __device__ __forceinline__ void operator()(AccRef acc, const pg8::Unit& u, int wr, int wc, int fr, int fq) const {
        const int row0 = launder(u.pm * 256 + wr * 64 + fr), colt = launder(u.pn * 256 + wc * 32 + 8 * fq);
#pragma unroll
        for (int ai = 0; ai < 2; ++ai)
#pragma unroll
            for (int m = 0; m < 4; ++m) { const int row = row0 + ai * 128 + m * 16;
                const f32x4 s0 = *(const f32x4*)(SQD + (size_t)row * 8), s1 = *(const f32x4*)(SQD + (size_t)row * 8 + 4);
                const float ss = ((s0[0] + s0[1]) + (s0[2] + s0[3])) + ((s1[0] + s1[1]) + (s1[2] + s1[3]));
                const float rs = 1.0f / sqrtf(ss * (1.0f / 512.0f) + LN_EPS);
#pragma unroll
                for (int bj = 0; bj < 2; ++bj) { const int col = colt + bj * 128, d8 = col % 96;
                    f32x4 v0 = acc[ai][bj][m][0] * rs, v1 = acc[ai][bj][m][1] * rs;
                    if (row >= CTX && d8 >= 64) { const int t = row - CTX; rope8(v0, v1, (d8 - 64) >> 3, t >> 6, t & 63); }
                    *(u32x4*)(Q + (size_t)row * 768 + col) = pack8(v0, v1); } }
    }
};
struct EpiKV {
    static constexpr bool PERM = true, MID = false;
    const float* SQKV; bf16_t *KF, *V;
    __device__ __forceinline__ void operator()(AccRef acc, const pg8::Unit& u, int wr, int wc, int fr, int fq) const {
        const int row0 = launder(u.pm * 256 + wr * 64 + fr), colt = launder(u.pn * 256 + wc * 32 + 8 * fq);
        const bool isK = u.pn < 2; bf16_t* base = isK ? KF : V; const int ld = isK ? 768 : 512, cstep = isK ? 192 : 128, coff = isK ? ((colt >> 6) * 96 + (colt & 63)) : colt - 512;
#pragma unroll
        for (int ai = 0; ai < 2; ++ai)
#pragma unroll
            for (int m = 0; m < 4; ++m) { const int row = row0 + ai * 128 + m * 16;
                const f32x4 s0 = *(const f32x4*)(SQKV + (size_t)row * 4);
                const float rs = 1.0f / sqrtf(((s0[0] + s0[1]) + (s0[2] + s0[3])) * (1.0f / 256.0f) + LN_EPS);
#pragma unroll
                for (int bj = 0; bj < 2; ++bj) { const f32x4 v0 = acc[ai][bj][m][0] * rs, v1 = acc[ai][bj][m][1] * rs;
                    *(u32x4*)(base + (size_t)row * ld + coff + bj * cstep) = pack8(v0, v1); } }
    }
};
struct EpiF2 {
    static constexpr bool PERM = true, MID = false;
    bf16_t* BR;
    __device__ __forceinline__ void operator()(AccRef acc, const pg8::Unit& u, int wr, int wc, int fr, int fq) const {
        const int po = u.pm, k10 = launder(wr * 64 + fr), colt = launder(u.pn * 256 + wc * 32 + 8 * fq);
#pragma unroll
        for (int ai = 0; ai < 2; ++ai)
#pragma unroll
            for (int m = 0; m < 4; ++m) { const int k1 = k10 + ai * 128 + m * 16;
#pragma unroll
                for (int bj = 0; bj < 2; ++bj) { const int j = colt + bj * 128; int row, ch;
                    if (j < 16384) { ch = j & 511; row = CTX + 32 * k1 + (j >> 9); } else { ch = j - 16384; row = k1; }
                    *(u32x4*)(BR + (size_t)row * KMERGE + 1024 + (ch >> 7) * 256 + po * 128 + (ch & 127)) = pack8(acc[ai][bj][m][0], acc[ai][bj][m][1]); } }
    }
};
struct EpiMerge {
    static constexpr bool PERM = true, MID = true;
    const unsigned char* GATES; bf16_t* Y;
    __device__ __forceinline__ void mid(f32x4 (&acc)[2][2][4][2], const pg8::Unit& u, int t, int wr, int wc, int fr, int fq) const {
        const int s = (t == 8) ? 0 : ((t == 16) ? 1 : 2);
        const int wv = launder(wr * 4 + wc), ln = launder(fq * 16 + fr);
#pragma unroll
        for (int ai = 0; ai < 2; ++ai)
#pragma unroll
            for (int m = 0; m < 4; ++m)
#pragma unroll
                for (int bj = 0; bj < 2; ++bj) { const u32x2 ga = *(const u32x2*)(GATES + gate_idx(s * 8 + u.pn, u.pm, ai, m, bj, wv, ln)), gb = *(const u32x2*)(GATES + gate_idx((s + 1) * 8 + u.pn, u.pm, ai, m, bj, wv, ln));
                    float fa[8], fb[8]; gate8_unpack(ga, fa); gate8_unpack(gb, fb);
#pragma unroll
                    for (int q = 0; q < 8; ++q) acc[ai][bj][m][q >> 2][q & 3] *= fa[q] * __builtin_amdgcn_rcpf(fmaxf(fb[q], 1e-30f)); }
    }
    __device__ __forceinline__ void operator()(AccRef acc, const pg8::Unit& u, int wr, int wc, int fr, int fq) const {
        const int row0 = launder(u.pm * 256 + wr * 64 + fr), colt = launder(u.pn * 256 + wc * 32 + 8 * fq);
#pragma unroll
        for (int ai = 0; ai < 2; ++ai)
#pragma unroll
            for (int m = 0; m < 4; ++m) { const int row = row0 + ai * 128 + m * 16;
#pragma unroll
                for (int bj = 0; bj < 2; ++bj) { const u32x2 g = *(const u32x2*)(GATES + gate_idx(24 + u.pn, u.pm, ai, m, bj, wr * 4 + wc, fq * 16 + fr));
                    float fg[8]; gate8_unpack(g, fg);
                    f32x4 v0 = acc[ai][bj][m][0], v1 = acc[ai][bj][m][1];
#pragma unroll
                    for (int q = 0; q < 4; ++q) { v0[q] *= fg[q]; v1[q] *= fg[4 + q]; }
                    *(u32x4*)(Y + (size_t)row * 2048 + colt + bj * 128) = pack8(v0, v1); } }
    }
};
struct EpiWo {
    static constexpr bool PERM = true, MID = false;
    bf16_t* MIX;
    __device__ __forceinline__ void operator()(AccRef acc, const pg8::Unit& u, int wr, int wc, int fr, int fq) const {
        const int row0 = launder(u.pm * 256 + wr * 64 + fr), colt = launder(u.pn * 256 + wc * 32 + 8 * fq);
#pragma unroll
        for (int ai = 0; ai < 2; ++ai)
#pragma unroll
            for (int m = 0; m < 4; ++m) { bf16_t* rowp = MIX + (size_t)(row0 + ai * 128 + m * 16) * 2048 + colt;
#pragma unroll
                for (int bj = 0; bj < 2; ++bj) *(u32x4*)(rowp + bj * 128) = pack8(acc[ai][bj][m][0], acc[ai][bj][m][1]); }
    }
};
struct EpiMoe1 {
    static constexpr bool PERM = true, MID = false;
    bf16_t* HS;
    __device__ __forceinline__ void operator()(AccRef acc, const pg8::Unit& u, int wr, int wc, int fr, int fq) const {
        const int row0 = launder(u.pm * 256 + wr * 64 + fr), c0 = launder((u.pn & 7) * 128 + wc * 32 + 8 * fq);
#pragma unroll
        for (int ai = 0; ai < 2; ++ai)
#pragma unroll
            for (int m = 0; m < 4; ++m) { f32x4 v0 = acc[ai][0][m][0], v1 = acc[ai][0][m][1]; const f32x4 g0 = acc[ai][1][m][0], g1 = acc[ai][1][m][1];
#pragma unroll
                for (int e = 0; e < 4; ++e) { v0[e] = fsilu(v0[e]) * g0[e]; v1[e] = fsilu(v1[e]) * g1[e]; }
                *(u32x4*)(HS + (size_t)(row0 + ai * 128 + m * 16) * 1024 + c0) = pack8(v0, v1); }
    }
};
struct EpiMoe1F8 {
    static constexpr bool PERM = true, MID = false;
    unsigned char* HS8;
    __device__ __forceinline__ void operator()(AccRef acc, const pg8::Unit& u, int wr, int wc, int fr, int fq) const {
        const int row0 = launder(u.pm * 256 + wr * 64 + fr), c0 = launder((u.pn & 7) * 128 + wc * 32 + 8 * fq);
#pragma unroll
        for (int ai = 0; ai < 2; ++ai)
#pragma unroll
            for (int m = 0; m < 4; ++m) { f32x4 v0 = acc[ai][0][m][0] * G8_INV, v1 = acc[ai][0][m][1] * G8_INV; const f32x4 g0 = acc[ai][1][m][0] * (G8_INV * HS8_SCALE), g1 = acc[ai][1][m][1] * (G8_INV * HS8_SCALE);
#pragma unroll
                for (int e = 0; e < 4; ++e) { v0[e] = fsilu(v0[e]) * g0[e]; v1[e] = fsilu(v1[e]) * g1[e]; }
                u32x2 w; w.x = pk_fp8x4(v0[0], v0[1], v0[2], v0[3]); w.y = pk_fp8x4(v1[0], v1[1], v1[2], v1[3]);
                *(u32x2*)(HS8 + (size_t)(row0 + ai * 128 + m * 16) * 1024 + c0) = w; }
    }
};
struct EpiMoe2 {
    static constexpr bool PERM = true, MID = false;
    const float* ROWG; bf16_t* YR;
    __device__ __forceinline__ void operator()(AccRef acc, const pg8::Unit& u, int wr, int wc, int fr, int fq) const {
        const int row0 = launder(u.pm * 256 + wr * 64 + fr), colt = launder((u.pn & 7) * 256 + wc * 32 + 8 * fq);
#pragma unroll
        for (int ai = 0; ai < 2; ++ai)
#pragma unroll
            for (int m = 0; m < 4; ++m) { const int row = row0 + ai * 128 + m * 16; const float gt = ROWG[row] * M2_INV;
#pragma unroll
                for (int bj = 0; bj < 2; ++bj) *(u32x4*)(YR + (size_t)row * 2048 + colt + bj * 128) = pack8(acc[ai][bj][m][0] * gt, acc[ai][bj][m][1] * gt); }
    }
};

template <bool MERGE>
__device__ __forceinline__ void ctx_gemm(const bf16_t* __restrict__ A, const bf16_t* __restrict__ Bt, int unit, const unsigned char* __restrict__ GATES, bf16_t* __restrict__ Y, bf16_t* __restrict__ MIX, LAS float* red) {
    constexpr int K = MERGE ? KMERGE : 2048, PER = K / 32 / 8, CH = MERGE ? 5 : 4;
    const int tid = launder((int)threadIdx.x), lane = tid & 63, w = __builtin_amdgcn_readfirstlane(tid >> 6), fr = lane & 15, fq = lane >> 4;
    const int row0 = (unit & 7) * 32, col0 = (unit >> 3) * 64, s0 = w * PER;
    const bf16_t* ap = A + (size_t)(row0 + fr) * K + s0 * 32 + fq * 8;
    const bf16_t* bp = Bt + (size_t)(col0 + fr) * K + s0 * 32 + fq * 8;
    f32x4 acc[2][4];
#pragma unroll
    for (int rb = 0; rb < 2; ++rb)
#pragma unroll
        for (int cb = 0; cb < 4; ++cb) acc[rb][cb] = (f32x4){0.f, 0.f, 0.f, 0.f};
#pragma nounroll
    for (int t0 = 0; t0 < PER; t0 += CH) {
        bf16x8 a[2][CH], b[4][CH];
#pragma unroll
        for (int t = 0; t < CH; ++t) {
#pragma unroll
            for (int rb = 0; rb < 2; ++rb) a[rb][t] = *(const bf16x8*)(ap + (size_t)(16 * rb) * K + (t0 + t) * 32);
#pragma unroll
            for (int cb = 0; cb < 4; ++cb) b[cb][t] = *(const bf16x8*)(bp + (size_t)(16 * cb) * K + (t0 + t) * 32); }
#pragma unroll
        for (int t = 0; t < CH; ++t) {
            if (MERGE) { const int st = s0 + t0 + t;
                if ((st == 16 || st == 32 || st == 64) && st != s0) { const int sg = (st == 16) ? 0 : ((st == 32) ? 1 : 2);
#pragma unroll
                    for (int rb = 0; rb < 2; ++rb)
#pragma unroll
                        for (int cb = 0; cb < 4; ++cb)
#pragma unroll
                            for (int i = 0; i < 4; ++i) { const int rw = row0 + 16 * rb + 4 * fq + i, cl = col0 + 16 * cb + fr;
                                acc[rb][cb][i] *= gate_rc(GATES, rw, sg, cl) * __builtin_amdgcn_rcpf(fmaxf(gate_rc(GATES, rw, sg + 1, cl), 1e-30f)); } } }
#pragma unroll
            for (int rb = 0; rb < 2; ++rb)
#pragma unroll
                for (int cb = 0; cb < 4; ++cb) acc[rb][cb] = __builtin_amdgcn_mfma_f32_16x16x32_bf16(a[rb][t], b[cb][t], acc[rb][cb], 0, 0, 0); }
    }
    if (MERGE) { const int sl = s0 + PER - 1, sg = sl < 16 ? 0 : (sl < 32 ? 1 : (sl < 64 ? 2 : 3));
#pragma unroll
        for (int rb = 0; rb < 2; ++rb)
#pragma unroll
            for (int cb = 0; cb < 4; ++cb)
#pragma unroll
                for (int i = 0; i < 4; ++i) acc[rb][cb][i] *= gate_rc(GATES, row0 + 16 * rb + 4 * fq + i, sg, col0 + 16 * cb + fr); }
#pragma unroll
    for (int rb = 0; rb < 2; ++rb)
#pragma unroll
        for (int cb = 0; cb < 4; ++cb)
#pragma unroll
            for (int i = 0; i < 4; ++i) red[(w * 32 + 16 * rb + 4 * fq + i) * 64 + 16 * cb + fr] = acc[rb][cb][i];
    __syncthreads();
    { const int r = tid >> 4, c4 = (tid & 15) * 4; f32x4 sacc = {0.f, 0.f, 0.f, 0.f};
#pragma unroll
      for (int ww = 0; ww < 8; ++ww) sacc += *(const LAS f32x4*)(red + (ww * 32 + r) * 64 + c4);
      u32x2 o; o.x = cvt_pk_bf16(sacc[0], sacc[1]); o.y = cvt_pk_bf16(sacc[2], sacc[3]); *(u32x2*)((MERGE ? Y : MIX) + (size_t)(row0 + r) * 2048 + col0 + c4) = o; }
    __syncthreads();
}

namespace attn {
constexpr int QBLK = 32, KVBLK = 64;
constexpr float SCALE = 0.10206207261596575f, THR = 8.f;
constexpr int SHM_V = 16384, SHM_K = 16384, SHM_ATTN = 2 * SHM_V + 2 * SHM_K + 8 * 64 * 4;
#define KSWZ(row, colB) ((row) * 256 + ((colB) ^ (((row) & 7) << 4)))
#define SBAR() __builtin_amdgcn_sched_barrier(0)
__device__ __forceinline__ int crow(int r, int hi) { return (r & 3) + 8 * (r >> 2) + 4 * hi; }
__device__ __forceinline__ void partialSM(f32x16& p0, f32x16& p1, float& m_reg, float& mn, float& alpha) {
    constexpr float C = SCALE * 1.4426950408889634f;
    float pmax = p0[0];
#pragma unroll
    for (int r = 1; r < 16; ++r) pmax = fmaxf(pmax, p0[r]);
#pragma unroll
    for (int r = 0; r < 16; ++r) pmax = fmaxf(pmax, p1[r]);
    { auto rr = __builtin_amdgcn_permlane32_swap(__float_as_uint(pmax), __float_as_uint(pmax), false, false);
      pmax = fmaxf(__uint_as_float(rr[0]), __uint_as_float(rr[1])); }
    if (__builtin_expect(__all(pmax - m_reg <= THR / SCALE), 1)) { mn = m_reg; alpha = 1.f; }
    else { mn = fmaxf(m_reg, pmax); alpha = __builtin_amdgcn_exp2f((m_reg - mn) * C); m_reg = mn; }
    const float mnC = -mn * C;
#pragma unroll
    for (int r = 0; r < 16; ++r) p0[r] = fmaf(p0[r], C, mnC);
#pragma unroll
    for (int r = 0; r < 16; ++r) p1[r] = fmaf(p1[r], C, mnC);
#pragma unroll
    for (int r = 0; r < 16; ++r) p0[r] = __builtin_amdgcn_exp2f(p0[r]);
}
__device__ __forceinline__ void finishSM(f32x16& p0, f32x16& p1, float alpha, float& l_reg, bf16x8& pa0, bf16x8& pa1, bf16x8& pa2, bf16x8& pa3) {
#pragma unroll
    for (int r = 0; r < 16; ++r) p1[r] = __builtin_amdgcn_exp2f(p1[r]);
    float ps = 0;
#pragma unroll
    for (int r = 0; r < 16; ++r) ps += p0[r];
#pragma unroll
    for (int r = 0; r < 16; ++r) ps += p1[r];
    { auto rr = __builtin_amdgcn_permlane32_swap(__float_as_uint(ps), __float_as_uint(ps), false, false);
      ps = __uint_as_float(rr[0]) + __uint_as_float(rr[1]); }
    l_reg = l_reg * alpha + ps;
#define PK4(P, BASE, OUT) do { unsigned a0 = cvt_pk_bf16(P[BASE + 0], P[BASE + 1]), a1 = cvt_pk_bf16(P[BASE + 2], P[BASE + 3]);   \
    unsigned b0 = cvt_pk_bf16(P[BASE + 4], P[BASE + 5]), b1 = cvt_pk_bf16(P[BASE + 6], P[BASE + 7]);                              \
    auto r0 = __builtin_amdgcn_permlane32_swap(a0, b0, false, false); auto r1 = __builtin_amdgcn_permlane32_swap(a1, b1, false, false); \
    u32x4 w = {r0[0], r1[0], r0[1], r1[1]}; OUT = __builtin_bit_cast(bf16x8, w); } while (0)
    PK4(p0, 0, pa0); PK4(p0, 8, pa1); PK4(p1, 0, pa2); PK4(p1, 8, pa3);
#undef PK4
}
__device__ __forceinline__ void qkt(f32x16& p0, f32x16& p1, const LAS unsigned char* Ks, const bf16x8 (&qr)[6], int r32, int hi) {
    p0 = f32x16{}; p1 = f32x16{};
#pragma unroll
    for (int d0 = 0; d0 < 6; ++d0) { const int cb = (d0 * 16 + hi * 8) * 2;
        const bf16x8 b0 = *(const LAS bf16x8*)(Ks + KSWZ(r32, cb));
        const bf16x8 b1 = *(const LAS bf16x8*)(Ks + KSWZ(32 + r32, cb));
        p0 = __builtin_amdgcn_mfma_f32_32x32x16_bf16(b0, qr[d0], p0, 0, 0, 0);
        p1 = __builtin_amdgcn_mfma_f32_32x32x16_bf16(b1, qr[d0], p1, 0, 0, 0); }
}
__device__ __forceinline__ int v_st(int k, int c) { const int kk = (k & ~0xC) | ((k & 4) << 1) | ((k & 8) >> 1); return ((kk >> 3) * 4 + (c >> 5)) * 512 + ((kk & 7) * 32 + (c & 31)) * 2; }
__device__ __forceinline__ int v_rd_base(int lane) { return ((lane & 3) << 3) | (((lane >> 2) & 3) << 6) | (((lane >> 4) & 1) << 5) | (((lane >> 5) & 1) << 8); }
constexpr int v_rd_off(int d0, int ks, int half) { return d0 * 512 + ks * 4096 + half * 2048; }
template <int OFF> __device__ __forceinline__ s16x4 tr_read(int vb) {
    s16x4 r; asm volatile("ds_read_b64_tr_b16 %0, %1 offset:%2" : "=&v"(r) : "v"(vb), "i"(OFF) : "memory"); return r;
}
template <int D0> __device__ __forceinline__ void pv_one(f32x16& od, int vb, bf16x8 pa0, bf16x8 pa1, bf16x8 pa2, bf16x8 pa3) {
    const s16x4 l0 = tr_read<v_rd_off(D0, 0, 0)>(vb), h0 = tr_read<v_rd_off(D0, 0, 1)>(vb), l1 = tr_read<v_rd_off(D0, 1, 0)>(vb), h1 = tr_read<v_rd_off(D0, 1, 1)>(vb);
    const s16x4 l2 = tr_read<v_rd_off(D0, 2, 0)>(vb), h2 = tr_read<v_rd_off(D0, 2, 1)>(vb), l3 = tr_read<v_rd_off(D0, 3, 0)>(vb), h3 = tr_read<v_rd_off(D0, 3, 1)>(vb);
    asm volatile("s_waitcnt lgkmcnt(0)" ::: "memory"); SBAR();
#define PK(L, H) (bf16x8){L[0], L[1], L[2], L[3], H[0], H[1], H[2], H[3]}
    od = __builtin_amdgcn_mfma_f32_32x32x16_bf16(pa0, PK(l0, h0), od, 0, 0, 0);
    od = __builtin_amdgcn_mfma_f32_32x32x16_bf16(pa1, PK(l1, h1), od, 0, 0, 0);
    od = __builtin_amdgcn_mfma_f32_32x32x16_bf16(pa2, PK(l2, h2), od, 0, 0, 0);
    od = __builtin_amdgcn_mfma_f32_32x32x16_bf16(pa3, PK(l3, h3), od, 0, 0, 0);
#undef PK
}
__device__ __forceinline__ void pv_both(f32x16& o0, f32x16& o1, int vb, bf16x8 pa0, bf16x8 pa1, bf16x8 pa2, bf16x8 pa3) {
    const s16x4 a0 = tr_read<v_rd_off(0, 0, 0)>(vb), b0 = tr_read<v_rd_off(0, 0, 1)>(vb), a1 = tr_read<v_rd_off(0, 1, 0)>(vb), b1 = tr_read<v_rd_off(0, 1, 1)>(vb);
    const s16x4 a2 = tr_read<v_rd_off(0, 2, 0)>(vb), b2 = tr_read<v_rd_off(0, 2, 1)>(vb), a3 = tr_read<v_rd_off(0, 3, 0)>(vb), b3 = tr_read<v_rd_off(0, 3, 1)>(vb);
    const s16x4 c0 = tr_read<v_rd_off(1, 0, 0)>(vb), d0 = tr_read<v_rd_off(1, 0, 1)>(vb), c1 = tr_read<v_rd_off(1, 1, 0)>(vb), d1 = tr_read<v_rd_off(1, 1, 1)>(vb);
    const s16x4 c2 = tr_read<v_rd_off(1, 2, 0)>(vb), d2 = tr_read<v_rd_off(1, 2, 1)>(vb), c3 = tr_read<v_rd_off(1, 3, 0)>(vb), d3 = tr_read<v_rd_off(1, 3, 1)>(vb);
    asm volatile("s_waitcnt lgkmcnt(0)" ::: "memory"); SBAR();
#define PK(L, H) (bf16x8){L[0], L[1], L[2], L[3], H[0], H[1], H[2], H[3]}
    o0 = __builtin_amdgcn_mfma_f32_32x32x16_bf16(pa0, PK(a0, b0), o0, 0, 0, 0);
    o1 = __builtin_amdgcn_mfma_f32_32x32x16_bf16(pa0, PK(c0, d0), o1, 0, 0, 0);
    o0 = __builtin_amdgcn_mfma_f32_32x32x16_bf16(pa1, PK(a1, b1), o0, 0, 0, 0);
    o1 = __builtin_amdgcn_mfma_f32_32x32x16_bf16(pa1, PK(c1, d1), o1, 0, 0, 0);
    o0 = __builtin_amdgcn_mfma_f32_32x32x16_bf16(pa2, PK(a2, b2), o0, 0, 0, 0);
    o1 = __builtin_amdgcn_mfma_f32_32x32x16_bf16(pa2, PK(c2, d2), o1, 0, 0, 0);
    o0 = __builtin_amdgcn_mfma_f32_32x32x16_bf16(pa3, PK(a3, b3), o0, 0, 0, 0);
    o1 = __builtin_amdgcn_mfma_f32_32x32x16_bf16(pa3, PK(c3, d3), o1, 0, 0, 0);
#undef PK
}
__device__ __forceinline__ void attn_unit(const bf16_t* __restrict__ Qb, const bf16_t* __restrict__ Kh, const bf16_t* __restrict__ Vh, bf16_t* __restrict__ Ob, int seq, LAS unsigned char* lds) {
    const int tid = launder((int)threadIdx.x), wid = tid >> 6, lane = tid & 63, r32 = lane & 31, hi = lane >> 5;
    LAS unsigned char* V_lds = lds; LAS unsigned char* K_lds = lds + 2 * SHM_V;
    LAS float* ws = (LAS float*)(lds + 2 * SHM_V + 2 * SHM_K) + wid * 64; LAS float* li_l = ws; LAS float* al_l = ws + 32;
    float m_reg = -1e30f, l_reg = 0; f32x16 o[2] = {}; bf16x8 qr[6];
    { const unsigned qoff = (unsigned)((wid * QBLK + r32) * 768 + hi * 8) * 2u;
#pragma unroll
      for (int d0 = 0; d0 < 6; ++d0) qr[d0] = *(const bf16x8*)((const char*)Qb + qoff + d0 * 32); }
    const int sr = tid >> 4, sc = (tid & 15) * 8; const bool kact = sc < 96, vact = sc < 64; const int sck = kact ? sc : 0, scv = vact ? sc : 0;
    const int vst0 = v_st(sr, scv), vst1 = v_st(32 + sr, scv);
    const int vb0 = (int)(uintptr_t)V_lds + v_rd_base(lane);
    struct { bf16x8 vs0, vs1, ks0, ks1; } sr_[2];
    const unsigned koff0 = (unsigned)(sr * 768 + sck) * 2u, koff1 = koff0 + 32u * 1536u, voff0 = (unsigned)(sr * 512 + scv) * 2u, voff1 = voff0 + 32u * 1024u;
#define SLOAD(i, k0) do { const char* kb_ = (const char*)Kh + (size_t)(k0) * 1536; const char* vb_ = (const char*)Vh + (size_t)(k0) * 1024; \
    sr_[i].vs0 = *(const bf16x8*)(vb_ + voff0); sr_[i].vs1 = *(const bf16x8*)(vb_ + voff1); sr_[i].ks0 = *(const bf16x8*)(kb_ + koff0); sr_[i].ks1 = *(const bf16x8*)(kb_ + koff1); } while (0)
#define SWRITE(b, i) do { if (vact) { *(LAS bf16x8*)(V_lds + (b) * SHM_V + vst0) = sr_[i].vs0; *(LAS bf16x8*)(V_lds + (b) * SHM_V + vst1) = sr_[i].vs1; } \
    if (kact) { const int kc = sc * 2; *(LAS bf16x8*)(K_lds + (b) * SHM_K + KSWZ(sr, kc)) = sr_[i].ks0; *(LAS bf16x8*)(K_lds + (b) * SHM_K + KSWZ(32 + sr, kc)) = sr_[i].ks1; } } while (0)
#define SWAIT() asm volatile("s_waitcnt vmcnt(4)" ::: "memory")
#define RESC(a) do { if (__any((a) < 1.f)) { if (hi == 0) al_l[r32] = (a); asm volatile("s_waitcnt lgkmcnt(0)" ::: "memory"); \
    _Pragma("unroll") for (int d = 0; d < 2; ++d) _Pragma("unroll") for (int r = 0; r < 16; ++r) o[d][r] *= al_l[crow(r, hi)]; } } while (0)
    f32x16 pA0, pA1, pB0, pB1; float mnA, mnB, alA, alB; bf16x8 pa0, pa1, pa2, pa3; const int NT = seq / KVBLK;
    constexpr int SE = 0, SO = 1;
    SLOAD(SE, 0); asm volatile("s_waitcnt vmcnt(0)" ::: "memory"); SWRITE(0, SE); __syncthreads();
    qkt(pA0, pA1, K_lds, qr, r32, hi); partialSM(pA0, pA1, m_reg, mnA, alA);
    SLOAD(SO, KVBLK); if (2 < NT) SLOAD(SE, 2 * KVBLK);
    SWAIT(); SWRITE(1, SO); __syncthreads();
    for (int j = 1; j + 1 < NT; j += 2) {
        SBAR(); qkt(pB0, pB1, K_lds + SHM_K, qr, r32, hi);
        finishSM(pA0, pA1, alA, l_reg, pa0, pa1, pa2, pa3); SBAR();
        SLOAD(SO, (j + 2) * KVBLK); SBAR();
        pv_both(o[0], o[1], vb0, pa0, pa1, pa2, pa3); partialSM(pB0, pB1, m_reg, mnB, alB);
        __syncthreads(); SWAIT(); SWRITE(0, SE);
        RESC(alB); __syncthreads();
        SBAR(); qkt(pA0, pA1, K_lds, qr, r32, hi);
        finishSM(pB0, pB1, alB, l_reg, pa0, pa1, pa2, pa3); SBAR();
        if (j + 3 < NT) SLOAD(SE, (j + 3) * KVBLK); SBAR();
        pv_both(o[0], o[1], vb0 + SHM_V, pa0, pa1, pa2, pa3); partialSM(pA0, pA1, m_reg, mnA, alA);
        __syncthreads(); SWAIT(); SWRITE(1, SO);
        RESC(alA); __syncthreads();
    }
    SBAR(); qkt(pB0, pB1, K_lds + SHM_K, qr, r32, hi);
    finishSM(pA0, pA1, alA, l_reg, pa0, pa1, pa2, pa3); SBAR();
    pv_both(o[0], o[1], vb0, pa0, pa1, pa2, pa3); partialSM(pB0, pB1, m_reg, mnB, alB);
    __syncthreads(); RESC(alB);
    finishSM(pB0, pB1, alB, l_reg, pa0, pa1, pa2, pa3); SBAR();
    pv_both(o[0], o[1], vb0 + SHM_V, pa0, pa1, pa2, pa3);
    if (hi == 0) li_l[r32] = l_reg; asm volatile("s_waitcnt lgkmcnt(0)" ::: "memory");
    { const unsigned ooff = (unsigned)launder((wid * QBLK + 4 * hi) * KMERGE + r32) * 2u;
#pragma unroll
      for (int r = 0; r < 16; ++r) { const int orow = crow(r, hi); const float rl = __builtin_amdgcn_rcpf(li_l[orow]);
#pragma unroll
        for (int d0 = 0; d0 < 2; ++d0) *(bf16_t*)((char*)Ob + ooff + (unsigned)(((r & 3) + 8 * (r >> 2)) * KMERGE + d0 * 32) * 2u) = (bf16_t)f2bf(o[d0][r] * rl); } }
    __syncthreads();
#undef SLOAD
#undef SWRITE
#undef SWAIT
#undef RESC
}
}

#define XB_TMO      128
#define XB_XCNT(j)  (256  + 64 * (j))
#define XB_XSUB(j)  (1280 + 64 * (j))
#define XB_XGEN(j)  (2304 + 64 * (j))
#define XB_TOP      3328
#define XB_TOPGEN   3392
#define XCD_BAR_WORDS 3456
#define XB_SPIN_CAP (1u << 18)
__device__ __forceinline__ unsigned xb_ld(unsigned* p)              { return __hip_atomic_load(p, __ATOMIC_RELAXED, __HIP_MEMORY_SCOPE_AGENT); }
__device__ __forceinline__ unsigned xb_add(unsigned* p, unsigned v) { return __hip_atomic_fetch_add(p, v, __ATOMIC_RELAXED, __HIP_MEMORY_SCOPE_AGENT); }
__device__ __forceinline__ unsigned xb_xcc_id() { return (unsigned)__builtin_amdgcn_s_getreg((3 << 11) | 20) & 0xFu; }
#define XB_SPIN(cond, bar) do { unsigned _sp = 0; while (cond) { __builtin_amdgcn_s_sleep(1); \
    if ((++_sp & 255u) == 0u) { if (xb_ld(&(bar)[XB_TMO])) break; if (_sp > XB_SPIN_CAP) { atomicAdd(&(bar)[XB_TMO], 1u); break; } } } } while (0)
struct XcdBarrier { unsigned* bar; unsigned x; volatile LAS unsigned* st; };
__device__ __forceinline__ XcdBarrier xcd_barrier_post(unsigned* bar, volatile LAS unsigned* st) {
    XcdBarrier b; b.bar = bar; b.x = xb_xcc_id(); b.st = st;
    if (threadIdx.x == 0) (void)xb_add(&bar[XB_XCNT(b.x)], 1u);
    return b;
}
__device__ __forceinline__ void xcd_barrier_complete(unsigned* bar, unsigned x, unsigned& nloc, unsigned& nx) {
    const unsigned G = gridDim.x * gridDim.y * gridDim.z;
    unsigned sum, cnt, mine, sp = 0u;
    for (;;) {
        sum = 0u; cnt = 0u; mine = 0u;
#pragma unroll
        for (unsigned j = 0; j < 16; ++j) { const unsigned c = xb_ld(&bar[XB_XCNT(j)]); sum += c; cnt += (c > 0u) ? 1u : 0u; mine = (j == x) ? c : mine; }
        if (sum == G) break;
        __builtin_amdgcn_s_sleep(1);
        if ((++sp & 255u) == 0u) { if (xb_ld(&bar[XB_TMO])) break; if (sp > XB_SPIN_CAP) { atomicAdd(&bar[XB_TMO], 1u); break; } }
    }
    nloc = mine > 0u ? mine : 1u; nx = cnt > 0u ? cnt : 1u;
}
__device__ __forceinline__ void xcd_barrier(const XcdBarrier& b) {
    asm volatile("s_waitcnt vmcnt(0)" ::: "memory");
    __syncthreads();
    if (threadIdx.x == 0) {
        unsigned* bar = b.bar;
        __builtin_amdgcn_s_waitcnt(0);
        unsigned nloc = b.st[0], nx = b.st[1];
        if (nloc == 0u) { xcd_barrier_complete(bar, b.x, nloc, nx); b.st[0] = nloc; b.st[1] = nx; }
        const unsigned old = xb_add(&bar[XB_XSUB(b.x)], 1u);
        const unsigned gen = old / nloc;
        if (old + 1u == (gen + 1u) * nloc) {
            __builtin_amdgcn_fence(__ATOMIC_RELEASE, "agent");
            asm volatile("s_waitcnt vmcnt(0)" ::: "memory");
            const unsigned og = xb_add(&bar[XB_TOP], 1u);
            const unsigned tg = og / nx;
            if (og + 1u == (tg + 1u) * nx) xb_add(&bar[XB_TOPGEN], 1u);
            else XB_SPIN(xb_ld(&bar[XB_TOPGEN]) == tg, bar);
            __builtin_amdgcn_fence(__ATOMIC_ACQUIRE, "agent");
            xb_add(&bar[XB_XGEN(b.x)], 1u);
            asm volatile("s_waitcnt vmcnt(0)" ::: "memory");
        } else {
            XB_SPIN(xb_ld(&bar[XB_XGEN(b.x)]) == gen, bar);
            __builtin_amdgcn_fence(__ATOMIC_ACQUIRE, "agent");
            asm volatile("s_waitcnt vmcnt(0)" ::: "memory");
        }
    }
    __syncthreads();
}

struct Params { const float* in[34]; float* out; unsigned char* ws; int ph_lo, ph_hi; };
enum { I_X = 0, I_C, I_CTX, I_CCTX, I_WADA, I_BADA, I_WIN, I_BIN, I_ALNG, I_ALNB, I_AWS, I_ABS, I_BWDW, I_BBDW, I_BLNG, I_BLNB, I_DQG, I_DWUQ, I_DKVG, I_DWUK, I_DWUV,
       I_WBR, I_WO, I_LN1G, I_LN1B, I_RWG, I_RBG, I_RWE, I_RBE, I_EW1, I_EW3, I_EW2, I_LN2G, I_LN2B };

template <class DestF>
__device__ __forceinline__ void transpose_item(const float* __restrict__ W, int ldw, int k0, int n0, bf16_t* __restrict__ WT, int ldt, int kofs, const float* __restrict__ kscale, DestF dest, LAS float* scr, int lane) {
#pragma unroll 8
    for (int i = 0; i < 32; ++i) { const int kk = 2 * i + (lane >> 5); float v = W[(size_t)(k0 + kk) * ldw + n0 + (lane & 31)]; if (kscale) v *= kscale[k0 + kk]; scr[kk * 33 + (lane & 31)] = v; }
    LDS_WAIT();
    const int c = lane & 7;
#pragma unroll
    for (int j = 0; j < 4; ++j) { const int n = (lane >> 3) + 8 * j; const LAS float* s = scr + (8 * c) * 33 + n;
        u32x4 o; o.x = cvt_pk_bf16(s[0 * 33], s[1 * 33]); o.y = cvt_pk_bf16(s[2 * 33], s[3 * 33]); o.z = cvt_pk_bf16(s[4 * 33], s[5 * 33]); o.w = cvt_pk_bf16(s[6 * 33], s[7 * 33]);
        *(u32x4*)(WT + (size_t)dest(n0 + n) * ldt + kofs + k0 + 8 * c) = o; }
    LDS_WAIT();
}
struct DestId { __device__ int operator()(int n) const { return n; } };
template <class DestF>
__device__ __forceinline__ void transpose8_item(const float* __restrict__ W, int ldw, int k0, int n0, unsigned char* __restrict__ WT8, int ldt, DestF dest, LAS unsigned char* scr8, int lane) {
    const int n = lane & 31, kh = lane >> 5; const float* wp = W + (size_t)(k0 + kh * 64) * ldw + n0 + n;
#pragma unroll
    for (int j = 0; j < 4; ++j) { float v[16];
#pragma unroll
        for (int i = 0; i < 16; ++i) v[i] = wp[(size_t)(j * 16 + i) * ldw] * W8_SCALE;
        u32x4 o; o.x = pk_fp8x4(v[0], v[1], v[2], v[3]); o.y = pk_fp8x4(v[4], v[5], v[6], v[7]); o.z = pk_fp8x4(v[8], v[9], v[10], v[11]); o.w = pk_fp8x4(v[12], v[13], v[14], v[15]);
        *(LAS u32x4*)(scr8 + n * 144 + kh * 64 + j * 16) = o; }
    LDS_WAIT();
#pragma unroll
    for (int j = 0; j < 4; ++j) { const int row = (lane >> 3) + 8 * j, seg = lane & 7;
        *(u32x4*)(WT8 + (size_t)dest(n0 + row) * ldt + k0 + seg * 16) = *(const LAS u32x4*)(scr8 + row * 144 + seg * 16); }
    LDS_WAIT();
}
struct DestWin { __device__ int operator()(int n) const {
    if (n < 1024) return n;
    if (n < 1536) { const int j = n - 1024; return 1024 + (j >> 7) * 256 + (j & 127); }
    if (n < 2048) { const int j = n - 1536; return 1024 + (j >> 7) * 256 + 128 + (j & 127); }
    if (n < 3328) return n;
    if (n < 3360) return 3328 + ropeperm(n - 3328);
    return n + 224; } };
struct DestUq { __device__ int operator()(int n) const { const int h = n / 96, d = n % 96; return d < 64 ? n : h * 96 + 64 + ropeperm(d - 64); } };
struct DestOff { int off; __device__ int operator()(int n) const { return n + off; } };
struct DestGlu { int off; __device__ int operator()(int n) const { return (n >> 7) * 256 + off + (n & 127); } };

__device__ __forceinline__ float mod_val(const float* __restrict__ MODP, const float* __restrict__ b_ada, int l, int which, int j, int k) {
    float s = b_ada[(size_t)l * 12288 + j * 2048 + k];
#pragma unroll
    for (int sl = 0; sl < NSLAB; ++sl) s += MODP[(((size_t)l * NSLAB + sl) * 2 + which) * 12288 + j * 2048 + k];
    return s;
}

__device__ __forceinline__ void mod_vec(LAS float* dst, const float* __restrict__ MODP, const float* __restrict__ b_ada, int l, int which, int j, float add0, int tid) {
    const int k = tid * 4; f32x4 s = *(const f32x4*)(b_ada + (size_t)l * 12288 + j * 2048 + k) + add0;
    f32x4 p[NSLAB];
#pragma unroll
    for (int sl = 0; sl < NSLAB; ++sl) p[sl] = *(const f32x4*)(MODP + (((size_t)l * NSLAB + sl) * 2 + which) * 12288 + j * 2048 + k);
#pragma unroll
    for (int sl = 0; sl < NSLAB; ++sl) s += p[sl];
    *(LAS f32x4*)(dst + k) = s;
}
__device__ __forceinline__ void mod_vec_fast(LAS float* dst, const float* __restrict__ MODV, int l, int which, int j, float add0, int tid) {
    const int k = tid * 4; *(LAS f32x4*)(dst + k) = *(const f32x4*)(MODV + (size_t)((l * 2 + which) * 6 + j) * 2048 + k) + add0;
}
__device__ __forceinline__ void fft32(float (&re)[32], float (&im)[32]) {
    constexpr float C32[16] = {1.0f, 0.9807852804032304f, 0.9238795325112867f, 0.8314696123025452f, 0.7071067811865476f, 0.5555702330196023f, 0.38268343236508984f, 0.19509032201612833f,
                               0.0f, -0.1950903220161282f, -0.3826834323650897f, -0.555570233019602f, -0.7071067811865475f, -0.8314696123025453f, -0.9238795325112867f, -0.9807852804032304f};
    constexpr float S32[16] = {0.0f, 0.19509032201612825f, 0.3826834323650898f, 0.5555702330196022f, 0.7071067811865476f, 0.8314696123025452f, 0.9238795325112867f, 0.9807852804032304f,
                               1.0f, 0.9807852804032304f, 0.9238795325112867f, 0.8314696123025455f, 0.7071067811865476f, 0.5555702330196022f, 0.3826834323650899f, 0.1950903220161286f};
#pragma unroll
    for (int s = 1; s <= 5; ++s) { const int m = 1 << s, h = m >> 1, step = 32 / m;
#pragma unroll
        for (int k = 0; k < 32; k += m)
#pragma unroll
            for (int j = 0; j < h; ++j) { const float c = C32[j * step], sn = S32[j * step]; const int a = k + j, b = k + j + h;
                const float tr = re[b] * c + im[b] * sn, ti = im[b] * c - re[b] * sn;
                re[b] = re[a] - tr; im[b] = im[a] - ti; re[a] += tr; im[a] += ti; } }
}
__host__ __device__ constexpr int brev5(int i) { return ((i & 1) << 4) | ((i & 2) << 2) | (i & 4) | ((i & 8) >> 2) | ((i & 16) >> 4); }
__device__ __forceinline__ void row_stats(const f32x4 (&v)[8], float& mean, float& rstd) {
    float s = 0.f;
#pragma unroll
    for (int j = 0; j < 8; ++j) s += (v[j][0] + v[j][1]) + (v[j][2] + v[j][3]);
    mean = wave_sum(s) * (1.0f / 2048.0f); float q = 0.f;
#pragma unroll
    for (int j = 0; j < 8; ++j) { const f32x4 d = v[j] - mean; q += (d[0] * d[0] + d[1] * d[1]) + (d[2] * d[2] + d[3] * d[3]); }
    rstd = 1.0f / sqrtf(wave_sum(q) * (1.0f / 2048.0f) + LN_EPS);
}

__device__ __forceinline__ void block_stats(const f32x4 v, LAS float* rs, int wave, float& mean, float& rstd) {
    const float s = wave_sum((v[0] + v[1]) + (v[2] + v[3])); rs[wave] = s; __syncthreads();
    float t = 0.f;
#pragma unroll
    for (int w = 0; w < 8; ++w) t += rs[w];
    mean = t * (1.0f / 2048.0f); const f32x4 d = v - mean;
    const float q = wave_sum((d[0] * d[0] + d[1] * d[1]) + (d[2] * d[2] + d[3] * d[3])); rs[8 + wave] = q; __syncthreads();
    t = 0.f;
#pragma unroll
    for (int w = 0; w < 8; ++w) t += rs[8 + w];
    rstd = 1.0f / sqrtf(t * (1.0f / 2048.0f) + LN_EPS);
}
__device__ __forceinline__ void route_pick(const float (&lgt)[36], const float* rbg, const float* rbe, int tok, int* TOKE, float* TOKG) {
    float gl[4];
#pragma unroll
    for (int c = 0; c < 4; ++c) gl[c] = lgt[c] + rbg[c];
    int gi = 0; float gm = gl[0];
#pragma unroll
    for (int c = 1; c < 4; ++c) if (gl[c] > gm) { gm = gl[c]; gi = c; }
    float gs = 0.f;
#pragma unroll
    for (int c = 0; c < 4; ++c) gs += expf(gl[c] - gm);
    const float gp = 1.0f / gs;
    float el[8];
#pragma unroll
    for (int c = 0; c < 8; ++c) { float v = 0.f;
#pragma unroll
        for (int g2 = 0; g2 < 4; ++g2) v = (gi == g2) ? lgt[4 + g2 * 8 + c] : v;
        el[c] = v + rbe[gi * 8 + c]; }
    int i0 = 0; float v0 = el[0];
#pragma unroll
    for (int c = 1; c < 8; ++c) if (el[c] > v0) { v0 = el[c]; i0 = c; }
    int i1 = -1; float v1 = -3.0e38f;
#pragma unroll
    for (int c = 0; c < 8; ++c) if (c != i0 && el[c] > v1) { v1 = el[c]; i1 = c; }
    const float e1 = expf(v1 - v0), p0 = 1.0f / (1.0f + e1), p1 = e1 / (1.0f + e1);
    TOKE[tok * 2] = gi * 8 + i0; TOKE[tok * 2 + 1] = gi * 8 + i1; TOKG[tok * 2] = p0 * gp; TOKG[tok * 2 + 1] = p1 * gp;
}

typedef const __attribute__((address_space(4))) Params* CP;
__device__ __forceinline__ CP kparams() { CP p = (CP)__builtin_amdgcn_kernarg_segment_ptr(); asm volatile("" : "+s"(p)); return p; }
#define WSP(T, off) ((T*)(ws + (off)))
__device__ __forceinline__ int launder_s(int x) { asm volatile("" : "+s"(x)); return x; }
#define PHASE_IDS const int tid = launder((int)threadIdx.x), lane = tid & 63, wave = __builtin_amdgcn_readfirstlane(tid >> 6); const int bx = launder_s((int)blockIdx.x), G = launder_s((int)gridDim.x), gw = bx * 8 + wave, NGW = G * 8; (void)lane; (void)gw; (void)NGW; (void)wave
#ifndef PH_MASK
#define PH_MASK 0xFFFFFFFFu
#endif
#define IN(k) (lo <= (k) && (k) < hi)
#define SEL(j) (((PH_MASK) >> (j)) & 1u)
#define SEAM(k) do { if (IN(k) && IN((k) + 1)) xcd_barrier(bar); } while (0)
template <int l>
__device__ __forceinline__ void layer_phases(const int lo, const int hi, const XcdBarrier& bar, LAS unsigned char* lds) {
        const int pb = 2 + 11 * l; const bool lastl = (l == 1);
        const int rowbeg = lastl ? CTX : 0;
        if (SEL(0) && IN(pb + 0)) {
            PHASE_IDS;
            CP Pp = kparams(); unsigned char* ws = Pp->ws;
            pg8::Gemm g{WSP(bf16_t, WS_HN), WSP(bf16_t, WS_WINT) + (size_t)l * NWIN * 2048, 2048};
            pg8::RectOrder S; S.init(32, 14, 1, G, bx, 0, lastl ? 12 : 0, lastl ? 2 : 14);
            EpiWin E{WSP(float, WS_BINP) + (size_t)l * NWIN, WSP(bf16_t, WS_ZA), WSP(bf16_t, WS_ZB), WSP(bf16_t, WS_ZCT), WSP(bf16_t, WS_ZD), WSP(bf16_t, WS_ZKV), WSP(bf16_t, WS_KF), WSP(bf16_t, WS_GATES), WSP(float, WS_SQD), WSP(float, WS_SQKV)};
            pg8::gemm_phase<EpiWin, pg8::RectOrder, true, true>(lds, g, S, E);
            {
                CP Pp2 = kparams(); unsigned char* ws2 = Pp2->ws;
                pg8::Gemm g8{(const bf16_t*)(ws2 + WS_HN8), (const bf16_t*)(ws2 + WS_WG8 + (size_t)l * 8192 * 2048), 1024};
                pg8::RectOrder S8; S8.init(lastl ? 32 : 33, 32, lastl ? 1 : 0, G, (bx + G - 206) % G);
                EpiGate8 E8{(const float*)(ws2 + WS_BINP) + (size_t)l * NWIN + 3584, ws2 + WS_GATES};
                pg8::gemm_phase<EpiGate8, pg8::RectOrder, true, true, true>(lds, g8, S8, E8);
            }
        }
        SEAM(pb + 0);
        if (SEL(1) && IN(pb + 1)) {
            PHASE_IDS;
            if (SEL(13)) { CP Pp = kparams(); unsigned char* ws = Pp->ws; pg8::Gemm g{WSP(bf16_t, WS_ZD), WSP(bf16_t, WS_WUQT) + (size_t)l * 768 * 512, 512}; pg8::RectOrder S; S.init(lastl ? 32 : 33, 3, lastl ? 1 : 0, G, bx);
              EpiQ E{WSP(float, WS_SQD), WSP(bf16_t, WS_Q)}; pg8::gemm_phase<EpiQ, pg8::RectOrder, true, true>(lds, g, S, E); }
            if (SEL(14)) { CP Pp = kparams(); unsigned char* ws = Pp->ws; pg8::Gemm g{WSP(bf16_t, WS_ZKV), WSP(bf16_t, WS_WUKVT) + (size_t)l * 1024 * 256, 256}; pg8::RectOrder S; S.init(33, 4, 0, G, (bx + G - 99) % G);
              EpiKV E{WSP(float, WS_SQKV), WSP(bf16_t, WS_KF), WSP(bf16_t, WS_V)}; pg8::gemm_phase<EpiKV, pg8::RectOrder, true, true>(lds, g, S, E); }
            __syncthreads();
            CP Pp = kparams(); unsigned char* ws = Pp->ws;
            bf16_t* ZA = WSP(bf16_t, WS_ZA); bf16_t* ZB = WSP(bf16_t, WS_ZB); bf16_t* ZCT = WSP(bf16_t, WS_ZCT); bf16_t* BR = WSP(bf16_t, WS_BR); bf16_t* GT = WSP(bf16_t, WS_GT);
            const int nchunk = lastl ? 64 : 66, chunk0 = lastl ? 2 : 0;
            const int nA = nchunk * 4, nB = lastl ? 256 : 264, nF = 256;
            for (int it = (bx + G - 231) % G; it < nA + nB + nF; it += G) {
                if (SEL(15) && it < nA) {
                    const int chunk = chunk0 + (it >> 2), g = it & 3, r0 = chunk * 128;
                    LAS bf16_t* T = (LAS bf16_t*)lds;
                    const float* lng = Pp->in[I_ALNG] + l * 512, *lnb = Pp->in[I_ALNB] + l * 512;
                    u32x4 rawv[16];
#pragma unroll
                    for (int rr = 0; rr < 16; ++rr) rawv[rr] = *(const u32x4*)(ZA + (size_t)(r0 + wave * 16 + rr) * 1024 + 512 + lane * 8);
#pragma unroll
                    for (int rr = 0; rr < 16; ++rr) { const int q = wave * 16 + rr; const u32x4 raw = rawv[rr];
                        float x[8]; x[0] = bflo(raw.x); x[1] = bfhi(raw.x); x[2] = bflo(raw.y); x[3] = bfhi(raw.y); x[4] = bflo(raw.z); x[5] = bfhi(raw.z); x[6] = bflo(raw.w); x[7] = bfhi(raw.w);
                        float s = 0.f;
#pragma unroll
                        for (int j = 0; j < 8; ++j) s += x[j];
                        const float mean = wave_sum(s) * (1.0f / 512.0f); float qq = 0.f;
#pragma unroll
                        for (int j = 0; j < 8; ++j) { const float d = x[j] - mean; qq += d * d; }
                        const float rstd = 1.0f / sqrtf(wave_sum(qq) * (1.0f / 512.0f) + LN_EPS);
                        if ((lane >> 4) == g) {
#pragma unroll
                            for (int j = 0; j < 8; ++j) { const int ch = lane * 8 + j; T[((lane & 15) * 8 + j) * 136 + q] = (bf16_t)f2bf((x[j] - mean) * rstd * lng[ch] + lnb[ch]); } }
                    }
                    __syncthreads();
                    const int fr = lane & 15, fq = lane >> 4;
                    const float* Wsp = Pp->in[I_AWS] + (((size_t)l * 4 + g) * 128 + wave * 16 + fr) * 128;
                    f32x4 accm[8];
#pragma unroll
                    for (int j = 0; j < 8; ++j) accm[j] = (f32x4){0.f, 0.f, 0.f, 0.f};
#pragma unroll
                    for (int ks = 0; ks < 4; ++ks) { const f32x4 w0 = *(const f32x4*)(Wsp + ks * 32 + fq * 8), w1 = *(const f32x4*)(Wsp + ks * 32 + fq * 8 + 4);
                        const u32x4 aw = pack8(w0, w1); const bf16x8 a = __builtin_bit_cast(bf16x8, aw);
#pragma unroll
                        for (int j = 0; j < 8; ++j) { const bf16x8 b = *(const LAS bf16x8*)(T + (j * 16 + fr) * 136 + ks * 32 + fq * 8);
                            accm[j] = __builtin_amdgcn_mfma_f32_16x16x32_bf16(a, b, accm[j], 0, 0, 0); } }
#pragma unroll
                    for (int i = 0; i < 4; ++i) { const int p = wave * 16 + fq * 4 + i; const float bs = Pp->in[I_ABS][((size_t)l * 4 + g) * 128 + p];
#pragma unroll
                        for (int j = 0; j < 8; ++j) { const int c = g * 128 + j * 16 + fr; const float uu = bf2f(ZA[(size_t)(r0 + p) * 1024 + c]);
                            BR[(size_t)(r0 + p) * KMERGE + c] = (bf16_t)f2bf(uu * (accm[j][i] + bs)); } }
                    __syncthreads();
                } else if (SEL(16) && it >= nA && it < nA + nB) {
                    const int ub = it - nA; int seq0, seqlen, t0;
                    if (lastl) { seq0 = CTX; seqlen = SEQ; t0 = ub * 32; } else if (ub < 8) { seq0 = 0; seqlen = CTX; t0 = ub * 32; } else { seq0 = CTX; seqlen = SEQ; t0 = (ub - 8) * 32; }
                    LAS bf16_t* Yin = (LAS bf16_t*)lds;
                    LAS float* Co = (LAS float*)(lds + 65536);
                    for (int pr = wave; pr < 62; pr += 8) { const int t = t0 - 15 + pr; u32x4 vv = {0u, 0u, 0u, 0u};
                        if (t >= 0 && t < seqlen) vv = *(const u32x4*)(ZB + (size_t)(seq0 + t) * 512 + lane * 8);
                        *(LAS u32x4*)(Yin + pr * 512 + lane * 8) = vv; }
                    __syncthreads();
                    { const int ch = tid; float wv[31];
#pragma unroll
                      for (int j = 0; j < 31; ++j) wv[j] = Pp->in[I_BWDW][((size_t)l * 31 + j) * 512 + ch];
                      const float bb = Pp->in[I_BBDW][l * 512 + ch];
                      float win[31];
#pragma unroll
                      for (int j = 0; j < 30; ++j) win[j + 1] = bf2f(Yin[j * 512 + ch]);
#pragma unroll
                      for (int p = 0; p < 32; ++p) {
#pragma unroll
                          for (int j = 0; j < 30; ++j) win[j] = win[j + 1];
                          win[30] = bf2f(Yin[(p + 30) * 512 + ch]);
                          float a = bb;
#pragma unroll
                          for (int j = 0; j < 31; ++j) a += win[j] * wv[j];
                          Co[p * 512 + ch] = a; } }
                    __syncthreads();
                    for (int pp = 0; pp < 4; ++pp) { const int p = wave * 4 + pp; const f32x4 x0 = *(const LAS f32x4*)(Co + p * 512 + lane * 8), x1 = *(const LAS f32x4*)(Co + p * 512 + lane * 8 + 4);
                        const float s = (x0[0] + x0[1]) + (x0[2] + x0[3]) + (x1[0] + x1[1]) + (x1[2] + x1[3]); const float mean = wave_sum(s) * (1.0f / 512.0f);
                        const f32x4 d0 = x0 - mean, d1 = x1 - mean; const float qq = (d0[0] * d0[0] + d0[1] * d0[1]) + (d0[2] * d0[2] + d0[3] * d0[3]) + (d1[0] * d1[0] + d1[1] * d1[1]) + (d1[2] * d1[2] + d1[3] * d1[3]);
                        const float rstd = 1.0f / sqrtf(wave_sum(qq) * (1.0f / 512.0f) + LN_EPS);
                        const float* lg = Pp->in[I_BLNG] + l * 512 + lane * 8; const float* lb = Pp->in[I_BLNB] + l * 512 + lane * 8;
                        f32x4 y0, y1;
#pragma unroll
                        for (int e = 0; e < 4; ++e) { y0[e] = fsilu(d0[e] * rstd * lg[e] + lb[e]); y1[e] = fsilu(d1[e] * rstd * lg[4 + e] + lb[4 + e]); }
                        *(u32x4*)(BR + (size_t)(seq0 + t0 + p) * KMERGE + 512 + lane * 8) = pack8(y0, y1); }
                    __syncthreads();
                } else if (SEL(17) && it >= nA + nB) {
                    const int uf = it - nA - nB, ch = uf * 2 + (tid >> 8), n1 = tid & 255;
                    const bf16_t* src = ZCT + (size_t)ch * NROW + CTX + n1;
                    float xr[32], xi[32];
#pragma unroll
                    for (int i = 0; i < 32; ++i) { xr[i] = bf2f(src[brev5(i) * 256]); xi[i] = 0.f; }
                    fft32(xr, xi);
#pragma unroll
                    for (int k2 = 0; k2 < 32; ++k2) { const float gr = xr[k2], gi = xi[k2];
                        const float rv = (float)(n1 * k2) * (1.0f / 8192.0f); const float ct = __builtin_amdgcn_cosf(rv), st = __builtin_amdgcn_sinf(rv);
                        const float sc = 0.17677669529663687f;
                        bf16_t* o = GT + (size_t)(k2 * 512 + ch) * 512 + n1;
                        o[0] = (bf16_t)f2bf((gr * ct + gi * st) * sc); o[256] = (bf16_t)f2bf((gi * ct - gr * st) * sc); }
                    if (!lastl) { bf16_t* o = GT + (size_t)(16384 + ch) * 512 + n1; o[0] = ZCT[(size_t)ch * NROW + n1]; o[256] = 0; }
                }
            }
        }
        SEAM(pb + 1);
        if (SEL(2) && IN(pb + 2)) {
            PHASE_IDS;
            CP Pp = kparams(); unsigned char* ws = Pp->ws; bf16_t* QB = WSP(bf16_t, WS_Q); bf16_t* KF = WSP(bf16_t, WS_KF); bf16_t* VB = WSP(bf16_t, WS_V); bf16_t* BR = WSP(bf16_t, WS_BR);
            if (SEL(18)) { const int h = bx & 7, qb = bx >> 3;
              for (int ua = bx; ua < 256; ua += G) { const int hh = ua & 7, qq = ua >> 3; (void)h; (void)qb;
                  attn::attn_unit(QB + (size_t)(CTX + qq * 256) * 768 + hh * 96, KF + hh * 96, VB + hh * 64, BR + (size_t)(CTX + qq * 256) * KMERGE + 2048 + hh * 64, NROW, lds); }
              if (!lastl) for (int ua = bx; ua < 8; ua += G) attn::attn_unit(QB + ua * 96, KF + ua * 96, VB + ua * 64, BR + 2048 + ua * 64, CTX, lds); }
            if (SEL(19)) { CP Pp2 = kparams(); unsigned char* ws = Pp2->ws; pg8::Gemm g{WSP(bf16_t, WS_FMAT), WSP(bf16_t, WS_GT), 512}; pg8::RectOrder S; S.init(2, lastl ? 64 : 66, 0, G, (bx + G - 8) % G);
              EpiF2 E{WSP(bf16_t, WS_BR)}; pg8::gemm_phase<EpiF2, pg8::RectOrder, true, true>(lds, g, S, E); }
        }
        SEAM(pb + 2);
        if (SEL(3) && IN(pb + 3)) {
            PHASE_IDS;
            CP Pp = kparams(); unsigned char* ws = Pp->ws;
            pg8::Gemm g{WSP(bf16_t, WS_BR), WSP(bf16_t, WS_WMT) + (size_t)l * 2048 * KMERGE, KMERGE}; pg8::RectOrder S; S.init(32, 8, 1, G, bx);
            EpiMerge E{WSP(unsigned char, WS_GATES), WSP(bf16_t, WS_Y)}; pg8::gemm_phase<EpiMerge, pg8::RectOrder, true, true>(lds, g, S, E);
            if (!lastl) { CP Pp2 = kparams(); unsigned char* ws2 = Pp2->ws;
                for (int uc = bx; uc < 256; uc += G) ctx_gemm<true>((const bf16_t*)(ws2 + WS_BR), (const bf16_t*)(ws2 + WS_WMT) + (size_t)l * 2048 * KMERGE, uc, (const unsigned char*)(ws2 + WS_GATES), (bf16_t*)(ws2 + WS_Y), nullptr, (LAS float*)lds); }
        }
        SEAM(pb + 3);
        if (SEL(4) && IN(pb + 4)) {
            PHASE_IDS;
            CP Pp = kparams(); unsigned char* ws = Pp->ws;
            pg8::Gemm g{WSP(bf16_t, WS_Y), WSP(bf16_t, WS_WOT) + (size_t)l * 2048 * 2048, 2048}; pg8::RectOrder S; S.init(32, 8, 1, G, bx);
            EpiWo E{WSP(bf16_t, WS_MIX)}; pg8::gemm_phase<EpiWo, pg8::RectOrder, true, true>(lds, g, S, E);
            if (!lastl) { CP Pp2 = kparams(); unsigned char* ws2 = Pp2->ws;
                for (int uc = bx; uc < 256; uc += G) ctx_gemm<false>((const bf16_t*)(ws2 + WS_Y), (const bf16_t*)(ws2 + WS_WOT) + (size_t)l * 2048 * 2048, uc, nullptr, nullptr, (bf16_t*)(ws2 + WS_MIX), (LAS float*)lds); }
        }
        SEAM(pb + 4);
        if (SEL(5) && IN(pb + 5)) {
            PHASE_IDS;
            CP Pp = kparams(); unsigned char* ws = Pp->ws; float* MODP = WSP(float, WS_MODP); bf16_t* MIX = WSP(bf16_t, WS_MIX); float* XA = WSP(float, WS_XA); float* XB = WSP(float, WS_XB); float* H32 = WSP(float, WS_H32); unsigned char* H8 = WSP(unsigned char, WS_H8);
#define PF_LOADX(r, XV) do { const float* xr_ = lastl ? XB + (size_t)(r) * D : ((r) < CTX ? Pp->in[I_CTX] + (size_t)(r) * D : Pp->in[I_X] + (size_t)((r) - CTX) * D); \
    _Pragma("unroll") for (int j = 0; j < 8; ++j) { XV[j] = *(const f32x4*)(xr_ + j * 256 + lane * 4); mv[j] = *(const u32x2*)(MIX + (size_t)(r) * D + j * 256 + lane * 4); } } while (0)
#define PF_XPTR(r) (lastl ? XB + (size_t)(r) * D : ((r) < CTX ? Pp->in[I_CTX] + (size_t)(r) * D : Pp->in[I_X] + (size_t)((r) - CTX) * D))
            const int nblk = (NROW - rowbeg) / 32, blk0 = bx + (lastl ? 0 : CTX / 32); const int r32 = lane & 31, kk = lane >> 5;
            f32x4 xv[8]; u32x2 mv[8]; f32x4 cx = {0.f, 0.f, 0.f, 0.f}; u32x2 cm = {0u, 0u};
            if (lastl && blk0 < nblk) PF_LOADX(rowbeg + blk0 * 32 + wave * 4, xv);
            if (!lastl && bx < CTX) { cx = *(const f32x4*)(Pp->in[I_CTX] + (size_t)bx * D + tid * 4); cm = *(const u32x2*)(MIX + (size_t)bx * D + tid * 4); }
            LAS float* MS = (LAS float*)lds;
            const float* MODV = WSP(float, WS_H32 + (2u << 20));
            mod_vec_fast(MS + 0 * 2048, MODV, l, 0, 2, 0.f, tid); mod_vec_fast(MS + 1 * 2048, MODV, l, 0, 4, 1.f, tid); mod_vec_fast(MS + 2 * 2048, MODV, l, 0, 3, 0.f, tid);
            const float* lg = Pp->in[I_LN1G] + l * D; const float* lb = Pp->in[I_LN1B] + l * D;
            *(LAS f32x4*)(MS + 3 * 2048 + tid * 4) = *(const f32x4*)(lg + tid * 4); *(LAS f32x4*)(MS + 4 * 2048 + tid * 4) = *(const f32x4*)(lb + tid * 4);
            __syncthreads();
            float* WR2 = WSP(float, WS_WR2); int* TOKE = WSP(int, WS_TOKE); float* TOKG = WSP(float, WS_TOKG);
            LAS float* HL = (LAS float*)(lds + 49152);
#define PF_LOAD(r, XV, MV) do { const float* xr_ = lastl ? XB + (size_t)(r) * D : ((r) < CTX ? Pp->in[I_CTX] + (size_t)(r) * D : Pp->in[I_X] + (size_t)((r) - CTX) * D); \
    _Pragma("unroll") for (int j = 0; j < 8; ++j) { const int c = j * 256 + lane * 4; XV[j] = *(const f32x4*)(xr_ + c); MV[j] = *(const u32x2*)(MIX + (size_t)(r) * D + c); } } while (0)
            if (!lastl) {
                for (int row = bx; row < CTX; row += G) {
                    LAS float* RS = (LAS float*)(lds + 49152); LAS float* hrow = RS + 64; LAS float* PLc = hrow + 2048; const int c = tid * 4;
                    const f32x4 x = (row == bx) ? cx : *(const f32x4*)(Pp->in[I_CTX] + (size_t)row * D + c); const u32x2 m = (row == bx) ? cm : *(const u32x2*)(MIX + (size_t)row * D + c);
                    const f32x4 mx = {bflo(m.x), bfhi(m.x), bflo(m.y), bfhi(m.y)};
                    f32x4 v = ALPHA * x + *(const f32x4*)(MODV + (size_t)((l * 2 + 1) * 6 + 2) * 2048 + c) * mx;
                    float mean, rstd; block_stats(v, RS, wave, mean, rstd);
                    v = (v - mean) * rstd * *(const f32x4*)(lg + c) + *(const f32x4*)(lb + c); *(f32x4*)(XA + (size_t)row * D + c) = v;
                    block_stats(v, RS + 16, wave, mean, rstd);
                    const f32x4 h = (v - mean) * rstd * (*(const f32x4*)(MODV + (size_t)((l * 2 + 1) * 6 + 4) * 2048 + c) + 1.0f) + *(const f32x4*)(MODV + (size_t)((l * 2 + 1) * 6 + 3) * 2048 + c);
                    *(unsigned*)(H8 + (size_t)row * D + c) = pk_fp8x4(h[0] * H8_SCALE, h[1] * H8_SCALE, h[2] * H8_SCALE, h[3] * H8_SCALE);
                    *(LAS f32x4*)(hrow + c) = h;
                    __syncthreads();
                    float acc = 0.f; const float* wp = WR2 + ((size_t)l * 256 + wave * 32) * 512 + (lane >> 5) * 128 + (lane & 31) * 4;
#pragma unroll 16
                    for (int q = 0; q < 64; ++q) { const f32x4 hv = *(const LAS f32x4*)(hrow + wave * 256 + q * 4), wv = *(const f32x4*)(wp + (size_t)(q >> 1) * 512 + (q & 1) * 256);
                        acc += (hv[0] * wv[0] + hv[1] * wv[1]) + (hv[2] * wv[2] + hv[3] * wv[3]); }
                    PLc[wave * 64 + lane] = acc;
                    __syncthreads();
                    if (tid < 36) { float s = 0.f;
#pragma unroll
                        for (int w = 0; w < 8; ++w) s += PLc[w * 64 + tid];
                        PLc[512 + tid] = s; }
                    __syncthreads();
                    if (tid == 0) { float lgt[36];
#pragma unroll
                        for (int cc = 0; cc < 36; ++cc) lgt[cc] = PLc[512 + cc];
                        route_pick(lgt, Pp->in[I_RBG] + l * 4, Pp->in[I_RBE] + l * 32, row, TOKE, TOKG); }
                    __syncthreads();
                }
            }
            for (int blk = blk0; blk < nblk; blk += G) {
                const int r0 = rowbeg + blk * 32 + wave * 4;
                f32x4 hreg[4][8];
                if (!lastl || blk != blk0) PF_LOADX(r0, xv);
#pragma unroll
                for (int i = 0; i < 4; ++i) { const int row = r0 + i;
                    const LAS float* MSw = MS + launder(lane * 4) - lane * 4;
                    f32x4 v[8];
#pragma unroll
                    for (int j = 0; j < 8; ++j) { const int c = j * 256 + lane * 4; const f32x4 mx = {bflo(mv[j].x), bfhi(mv[j].x), bflo(mv[j].y), bfhi(mv[j].y)};
                        v[j] = ALPHA * xv[j] + *(const LAS f32x4*)(MSw + c) * mx; }
                    if (i < 3) PF_LOADX(row + 1, xv);
                    float mean, rstd; row_stats(v, mean, rstd);
#pragma unroll
                    for (int j = 0; j < 8; ++j) { const int c = j * 256 + lane * 4; v[j] = (v[j] - mean) * rstd * *(const LAS f32x4*)(MSw + 3 * 2048 + c) + *(const LAS f32x4*)(MSw + 4 * 2048 + c); *(f32x4*)(XA + (size_t)row * D + c) = v[j]; }
                    row_stats(v, mean, rstd);
#pragma unroll
                    for (int j = 0; j < 8; ++j) { const int c = j * 256 + lane * 4;
                        const f32x4 h = (v[j] - mean) * rstd * *(const LAS f32x4*)(MSw + 2048 + c) + *(const LAS f32x4*)(MSw + 4096 + c);
                        hreg[i][j] = h; *(unsigned*)(H8 + (size_t)row * D + c) = pk_fp8x4(h[0] * H8_SCALE, h[1] * H8_SCALE, h[2] * H8_SCALE, h[3] * H8_SCALE); }
                    __builtin_amdgcn_sched_barrier(0);
                }
                f32x16 a0 = {}, a1 = {};
                LAS bf16_t* HH = (LAS bf16_t*)HL; LAS bf16_t* HO = HH + 32 * 520;
                const bf16_t* WRH = WSP(bf16_t, WS_H32);
#pragma unroll
                for (int c = 0; c < 4; ++c) {
                    __builtin_amdgcn_sched_barrier(0);
                    const bf16_t* wp = WRH + ((((size_t)l * 128 + c * 32 + wave * 4) * 2) * 64 + launder(lane)) * 16;
                    bf16x8 bw[4][4];
#pragma unroll
                    for (int t = 0; t < 1; ++t) { bw[t][0] = *(const bf16x8*)(wp + (size_t)t * 2048); bw[t][1] = *(const bf16x8*)(wp + (size_t)t * 2048 + 8); bw[t][2] = *(const bf16x8*)(wp + (size_t)t * 2048 + 1024); bw[t][3] = *(const bf16x8*)(wp + (size_t)t * 2048 + 1032); }
#pragma unroll
                    for (int i = 0; i < 4; ++i)
#pragma unroll
                        for (int jj = 0; jj < 2; ++jj) { const f32x4 h4 = hreg[i][2 * c + jj]; u32x2 hw, lw;
                            hw.x = cvt_pk_bf16(h4[0], h4[1]); hw.y = cvt_pk_bf16(h4[2], h4[3]);
                            lw.x = cvt_pk_bf16(h4[0] - bflo(hw.x), h4[1] - bfhi(hw.x)); lw.y = cvt_pk_bf16(h4[2] - bflo(hw.y), h4[3] - bfhi(hw.y));
                            *(LAS u32x2*)(HH + (wave * 4 + i) * 520 + jj * 256 + lane * 4) = hw; *(LAS u32x2*)(HO + (wave * 4 + i) * 520 + jj * 256 + lane * 4) = lw; }
                    __syncthreads();
                    const LAS bf16_t* hp = HH + r32 * 520 + wave * 64 + kk * 8;
#pragma unroll
                    for (int t = 1; t < 4; ++t) { bw[t][0] = *(const bf16x8*)(wp + (size_t)t * 2048); bw[t][1] = *(const bf16x8*)(wp + (size_t)t * 2048 + 8); bw[t][2] = *(const bf16x8*)(wp + (size_t)t * 2048 + 1024); bw[t][3] = *(const bf16x8*)(wp + (size_t)t * 2048 + 1032); }
#pragma unroll
                    for (int t = 0; t < 4; ++t) { const bf16x8 ah = *(const LAS bf16x8*)(hp + t * 16), al = *(const LAS bf16x8*)(hp + 32 * 520 + t * 16);
                        a0 = __builtin_amdgcn_mfma_f32_32x32x16_bf16(ah, bw[t][0], a0, 0, 0, 0); a1 = __builtin_amdgcn_mfma_f32_32x32x16_bf16(ah, bw[t][2], a1, 0, 0, 0);
                        a0 = __builtin_amdgcn_mfma_f32_32x32x16_bf16(ah, bw[t][1], a0, 0, 0, 0); a1 = __builtin_amdgcn_mfma_f32_32x32x16_bf16(ah, bw[t][3], a1, 0, 0, 0);
                        a0 = __builtin_amdgcn_mfma_f32_32x32x16_bf16(al, bw[t][0], a0, 0, 0, 0); a1 = __builtin_amdgcn_mfma_f32_32x32x16_bf16(al, bw[t][2], a1, 0, 0, 0); }
                    __syncthreads();
                }
                LAS float* PL = HL;
#pragma unroll
                for (int r = 0; r < 16; ++r) { const int tok = (r & 3) + 8 * (r >> 2) + 4 * kk; PL[(wave * 64 + r32) * 32 + tok] = a0[r]; PL[(wave * 64 + 32 + r32) * 32 + tok] = a1[r]; }
                __syncthreads();
                LAS float* SUMS = PL + 8 * 64 * 32;
#pragma unroll
                for (int k = 0; k < 3; ++k) { const int p = tid + k * 512; if (p < 36 * 32) { float s = 0.f;
#pragma unroll
                        for (int w = 0; w < 8; ++w) s += PL[(w * 64 + (p >> 5)) * 32 + (p & 31)];
                        SUMS[p] = s; } }
                __syncthreads();
                if (tid < 32) { float lgt[36];
#pragma unroll
                    for (int c = 0; c < 36; ++c) { lgt[c] = SUMS[c * 32 + tid]; }
                    route_pick(lgt, Pp->in[I_RBG] + l * 4, Pp->in[I_RBE] + l * 32, blk * 32 + tid, TOKE, TOKG); }
                __syncthreads();
            }
        }
        SEAM(pb + 5);
        if (SEL(7) && IN(pb + 7)) {
            PHASE_IDS;
            CP Pp = kparams(); unsigned char* ws = Pp->ws; unsigned char* H8 = WSP(unsigned char, WS_H8); int* TOKE = WSP(int, WS_TOKE); float* TOKG = WSP(float, WS_TOKG); int* POS = WSP(int, WS_POS);
            float* ROWG = WSP(float, WS_ROWG); int* TILEE = WSP(int, WS_TILEE); int* ROWTOK = WSP(int, WS_XS8);
            const int ntok = NROW - rowbeg, nent = ntok * 2, per = nent / G;
            LAS int* cnt_tot = (LAS int*)lds; LAS int* cnt_bef = cnt_tot + 32; LAS int* pstart = cnt_tot + 64; LAS int* ent_e = cnt_tot + 128; LAS int* ent_d = cnt_tot + 256;
            const int e_lo = bx * per;
            LAS unsigned* hist = (LAS unsigned*)(lds + 2048);
            const int my_e = tid < per ? TOKE[e_lo + tid] : 0; const float my_g = tid < per ? TOKG[e_lo + tid] : 0.f;
            { int ev[33];
#pragma unroll
              for (int q = 0; q < 33; ++q) { const int i = tid + q * 512; ev[q] = i < nent ? TOKE[i] : -1; }
#pragma unroll
              for (int e = 0; e < NEXP; ++e) hist[e * 512 + tid] = 0u;
#pragma unroll
              for (int q = 0; q < 33; ++q) { const int i = tid + q * 512; if (ev[q] >= 0) hist[ev[q] * 512 + tid] += 1u + ((i < e_lo) ? 65536u : 0u); } }
            __syncthreads();
#pragma unroll
            for (int ee = 0; ee < 4; ++ee) { const int e = wave * 4 + ee; unsigned s = 0u;
#pragma unroll
                for (int k = 0; k < 8; ++k) s += hist[e * 512 + k * 64 + lane];
                const float tl = wave_sum((float)(s & 0xffffu)), tb = wave_sum((float)(s >> 16));
                if (lane == 0) { cnt_tot[e] = (int)tl; cnt_bef[e] = (int)tb; } }
            __syncthreads();
            if (tid == 0) { int acc = 0, nt = 0; for (int e = 0; e < NEXP; ++e) { pstart[e] = acc; const int pt = (cnt_tot[e] + 255) >> 8; if (bx == 0) for (int q = 0; q < pt; ++q) TILEE[nt + q] = e | ((q == pt - 1 && cnt_tot[e] - q * 256 <= 128) ? 256 : 0); nt += pt; acc += pt * 256; } if (bx == 0) TILEE[100] = nt; }
            if (tid < per) ent_e[tid] = my_e;
            __syncthreads();
            if (tid < per) { const int e = ent_e[tid]; int rk = cnt_bef[e]; for (int j = 0; j < tid; ++j) rk += (ent_e[j] == e) ? 1 : 0; const int dst = pstart[e] + rk; ent_d[tid] = dst;
                POS[e_lo + tid] = dst; ROWG[dst] = my_g; ROWTOK[dst] = rowbeg + ((e_lo + tid) >> 1); }
            if (bx < NEXP) { const int e = bx, c = cnt_tot[e], pend = pstart[e] + (((c + 255) >> 8) << 8);
                for (int rr = pstart[e] + c + tid; rr < pend; rr += 512) { ROWG[rr] = 0.f; ROWTOK[rr] = rowbeg; } }
            __syncthreads();
        }
        SEAM(pb + 7);
        if (SEL(8) && IN(pb + 8)) {
            PHASE_IDS;
            CP Pp = kparams(); unsigned char* ws = Pp->ws; int* TILEE = WSP(int, WS_TILEE);
            const int vcu = (G % 8 == 0) ? (bx % 8) * (G / 8) + bx / 8 : bx;
            const int nt = TILEE[100];
            pg8::Gemm g{(const bf16_t*)(ws + WS_H8), (const bf16_t*)(ws + WS_W13T8 + (size_t)l * 32 * 2048 * 2048), 1024};
            pg8::MoeGatherOrder S; S.tile_e = TILEE; S.nunits = nt * 8; S.G = G; S.c = vcu; S.rowtok = WSP(int, WS_XS8);
            EpiMoe1F8 E{ws + WS_HS8}; pg8::gemm_phase<EpiMoe1F8, pg8::MoeGatherOrder, true, true, true>(lds, g, S, E);
        }
        SEAM(pb + 8);
        if (SEL(9) && IN(pb + 9)) {
            PHASE_IDS;
            CP Pp = kparams(); unsigned char* ws = Pp->ws; int* TILEE = WSP(int, WS_TILEE);
            const int vcu = (G % 8 == 0) ? (bx % 8) * (G / 8) + bx / 8 : bx;
            const int nt = TILEE[100];
            pg8::Gemm g{(const bf16_t*)(ws + WS_HS8), (const bf16_t*)(ws + WS_W2T8 + (size_t)l * 32 * 2048 * 1024), 512}; pg8::MoeOrder S{TILEE, nt * 8, G, vcu};
            EpiMoe2 E{WSP(float, WS_ROWG), WSP(bf16_t, WS_YR)}; pg8::gemm_phase<EpiMoe2, pg8::MoeOrder, true, true, true>(lds, g, S, E);
        }
        SEAM(pb + 9);
        if (SEL(10) && IN(pb + 10)) {
            PHASE_IDS;
            CP Pp = kparams(); unsigned char* ws = Pp->ws; float* MODP = WSP(float, WS_MODP); float* XA = WSP(float, WS_XA); float* XB = WSP(float, WS_XB); bf16_t* HN = WSP(bf16_t, WS_HN); bf16_t* YR = WSP(bf16_t, WS_YR); int* POS = WSP(int, WS_POS); unsigned char* HN8 = WSP(unsigned char, WS_HN8);
            f32x4 xv[8]; u32x2 av[8], bv[8]; int p0c = 0, p1c = 0, p0n = 0, p1n = 0;
#define PK_LOAD(r, P0, P1, XV, AV, BV) do { const bf16_t* y0_ = YR + (size_t)(P0) * D; const bf16_t* y1_ = YR + (size_t)(P1) * D; \
    _Pragma("unroll") for (int j = 0; j < 8; ++j) { const int c = j * 256 + lane * 4; XV[j] = *(const f32x4*)(XA + (size_t)(r) * D + c); AV[j] = *(const u32x2*)(y0_ + c); BV[j] = *(const u32x2*)(y1_ + c); } } while (0)
            { const int r0_ = rowbeg + gw; if (r0_ < NROW) { p0c = POS[(r0_ - rowbeg) * 2]; p1c = POS[(r0_ - rowbeg) * 2 + 1]; }
              if (r0_ + NGW < NROW) { p0n = POS[(r0_ + NGW - rowbeg) * 2]; p1n = POS[(r0_ + NGW - rowbeg) * 2 + 1]; }
              if (r0_ < NROW) PK_LOAD(r0_, p0c, p1c, xv, av, bv); }
            LAS float* MS = (LAS float*)lds;
#pragma unroll
            for (int which = 0; which < 2; ++which) { mod_vec_fast(MS + (which * 3 + 0) * 2048, WSP(float, WS_H32 + (2u << 20)), l, which, 5, 0.f, tid);
                if (!lastl) { mod_vec_fast(MS + (which * 3 + 1) * 2048, WSP(float, WS_H32 + (2u << 20)), 1, which, 1, 1.f, tid); mod_vec_fast(MS + (which * 3 + 2) * 2048, WSP(float, WS_H32 + (2u << 20)), 1, which, 0, 0.f, tid); } }
            const float* lg = Pp->in[I_LN2G] + l * D; const float* lb = Pp->in[I_LN2B] + l * D;
            *(LAS f32x4*)(MS + 6 * 2048 + tid * 4) = *(const f32x4*)(lg + tid * 4); *(LAS f32x4*)(MS + 7 * 2048 + tid * 4) = *(const f32x4*)(lb + tid * 4);
            __syncthreads();
            for (int row = rowbeg + gw; row < NROW; row += NGW) {
                const int which = row < CTX ? 1 : 0;
                int p0nn = 0, p1nn = 0;
                if (row + 2 * NGW < NROW) { p0nn = POS[(row + 2 * NGW - rowbeg) * 2]; p1nn = POS[(row + 2 * NGW - rowbeg) * 2 + 1]; }
                f32x4 v[8];
#pragma unroll
                for (int j = 0; j < 8; ++j) { const int c = j * 256 + lane * 4; const u32x2 a = av[j], b = bv[j];
                    const f32x4 f = {bflo(a.x) + bflo(b.x), bfhi(a.x) + bfhi(b.x), bflo(a.y) + bflo(b.y), bfhi(a.y) + bfhi(b.y)};
                    v[j] = ALPHA * xv[j] + *(const LAS f32x4*)(MS + (which * 3) * 2048 + c) * f; }
                if (row + NGW < NROW) PK_LOAD(row + NGW, p0n, p1n, xv, av, bv);
                p0n = p0nn; p1n = p1nn;
                float mean, rstd; row_stats(v, mean, rstd);
                float* orow = lastl ? Pp->out + (size_t)(row - CTX) * D : XB + (size_t)row * D;
#pragma unroll
                for (int j = 0; j < 8; ++j) { const int c = j * 256 + lane * 4; v[j] = (v[j] - mean) * rstd * *(const LAS f32x4*)(MS + 6 * 2048 + c) + *(const LAS f32x4*)(MS + 7 * 2048 + c); *(f32x4*)(orow + c) = v[j]; }
                if (!lastl) { row_stats(v, mean, rstd);
#pragma unroll
                    for (int j = 0; j < 8; ++j) { const int c = j * 256 + lane * 4;
                        const f32x4 h = (v[j] - mean) * rstd * *(const LAS f32x4*)(MS + (which * 3 + 1) * 2048 + c) + *(const LAS f32x4*)(MS + (which * 3 + 2) * 2048 + c);
                        u32x2 w; w.x = cvt_pk_bf16(h[0], h[1]); w.y = cvt_pk_bf16(h[2], h[3]); *(u32x2*)(HN + (size_t)row * D + c) = w;
                        *(unsigned*)(HN8 + (size_t)row * D + c) = pk_fp8x4(h[0] * H8_SCALE, h[1] * H8_SCALE, h[2] * H8_SCALE, h[3] * H8_SCALE); } }
            }
        }
        SEAM(pb + 10);
}
__global__ void __launch_bounds__(512, 2) fwd_kernel(Params P_unused) {
    extern __shared__ __attribute__((aligned(16))) unsigned char lds_raw[];
    LAS unsigned char* lds = (LAS unsigned char*)lds_raw;
    volatile LAS unsigned* MISC = (volatile LAS unsigned*)(lds + MISC_OFF);
    const int tid = threadIdx.x, lane = tid & 63, wave = __builtin_amdgcn_readfirstlane(tid >> 6);
    const int G = gridDim.x, bx = blockIdx.x;
    const int gw = bx * 8 + wave, NGW = G * 8;
    int lo, hi; unsigned* barw;
    { CP Pp = kparams(); lo = Pp->ph_lo; hi = Pp->ph_hi; barw = (unsigned*)(Pp->ws + WS_CTL) + CW_BAR; }
    for (int u = tid; u < (LDS_BYTES - RING_BYTES) / 4; u += 512) ((LAS unsigned*)(lds + RING_BYTES))[u] = 0u;
    __syncthreads();
    XcdBarrier bar; bar.bar = barw; bar.x = 0; bar.st = nullptr;
    if (hi - lo > 1) bar = xcd_barrier_post(barw, MISC + 8);

    if (SEL(11) && IN(0)) {
            PHASE_IDS;
        CP Pp = kparams(); unsigned char* ws = Pp->ws;
        float* MODP = WSP(float, WS_MODP); bf16_t* WINT = WSP(bf16_t, WS_WINT); float* BINP = WSP(float, WS_BINP); bf16_t* WMT = WSP(bf16_t, WS_WMT); bf16_t* WOT = WSP(bf16_t, WS_WOT);
        bf16_t* WUQT = WSP(bf16_t, WS_WUQT); bf16_t* WUKVT = WSP(bf16_t, WS_WUKVT); float* WR2 = WSP(float, WS_WR2); bf16_t* FMAT = WSP(bf16_t, WS_FMAT); unsigned char* WG8 = WSP(unsigned char, WS_WG8); unsigned char* W13T8 = WSP(unsigned char, WS_W13T8); unsigned char* W2T8 = WSP(unsigned char, WS_W2T8);
        LAS float* scr = (LAS float*)(lds + wave * 16384); LAS unsigned char* scr8 = lds + wave * 16384 + 8704;
        constexpr int N_GEMV = 2 * NSLAB * 48;
        constexpr int N_WIN = 2 * 32 * 105, N_WG8 = 2 * 16 * 256, N_BRW = 2 * 3 * 8 * 64, N_WC = 2 * 4 * 2 * 4 * 32, N_WO = 2 * 32 * 64, N_UQ = 2 * 8 * 24, N_UKV = 2 * 2 * 4 * 16;
        constexpr int N_W1 = 2 * 32 * 16 * 32, N_W2 = 2 * 32 * 8 * 64, N_FM = 512, N_BIN = 2 * 46, N_WR = 2 * 256, N_ZP = 2 * 224;
        constexpr int NITEMS = N_GEMV + N_WIN + N_WG8 + N_BRW + N_WC + N_WO + N_UQ + N_UKV + 2 * N_W1 + N_W2 + N_FM + N_BIN + N_WR + N_ZP;
        for (int it = gw; it < NITEMS; it += NGW) {
            int r = it;
            if (r < N_GEMV) {
                const int l = r / (NSLAB * 48), sl = (r / 48) % NSLAB, cb = r % 48;
                const float* W = Pp->in[I_WADA] + (size_t)l * 2048 * 12288 + (size_t)(sl * 128) * 12288 + cb * 256 + lane * 4;
                const float c0 = Pp->in[I_C][sl * 128 + lane], c1 = Pp->in[I_C][sl * 128 + 64 + lane], x0 = Pp->in[I_CCTX][sl * 128 + lane], x1 = Pp->in[I_CCTX][sl * 128 + 64 + lane];
                const float sl0 = fsilu(c0), sl1 = fsilu(c1), sx0 = fsilu(x0), sx1 = fsilu(x1);
                f32x4 al = {0.f, 0.f, 0.f, 0.f}, ac = {0.f, 0.f, 0.f, 0.f};
#pragma unroll 8
                for (int k = 0; k < 64; ++k) { const f32x4 w = *(const f32x4*)(W + (size_t)k * 12288); al += w * __shfl(sl0, k); ac += w * __shfl(sx0, k); }
#pragma unroll 8
                for (int k = 0; k < 64; ++k) { const f32x4 w = *(const f32x4*)(W + (size_t)(64 + k) * 12288); al += w * __shfl(sl1, k); ac += w * __shfl(sx1, k); }
                float* o = MODP + (((size_t)l * NSLAB + sl) * 2) * 12288 + cb * 256 + lane * 4;
                *(f32x4*)o = al; *(f32x4*)(o + 12288) = ac; continue; }
            r -= N_GEMV;
            if (r < N_WIN) { const int l = r / (32 * 105), q = r % (32 * 105), kb = q / 105, nb = q % 105;
                transpose_item(Pp->in[I_WIN] + (size_t)l * 2048 * DIN, DIN, kb * 64, nb * 32, WINT + (size_t)l * NWIN * 2048, 2048, 0, nullptr, DestWin(), scr, lane); continue; }
            r -= N_WIN;
            if (r < N_WG8) { const int l = r / (16 * 256), q = r % (16 * 256);
                transpose8_item(Pp->in[I_WIN] + (size_t)l * 2048 * DIN + 3360, DIN, (q / 256) * 128, (q % 256) * 32, WG8 + (size_t)l * 8192 * 2048, 2048, DestId(), scr8, lane); continue; }
            r -= N_WG8;
            if (r < N_BRW) { const int l = r / 1536, q = r % 1536, bi = q / 512, q2 = q % 512, kb = q2 / 64, nb = q2 % 64; const int br = bi == 2 ? 3 : bi;
                transpose_item(Pp->in[I_WBR] + ((size_t)l * 4 + br) * 512 * 2048, 2048, kb * 64, nb * 32, WMT + (size_t)l * 2048 * KMERGE, KMERGE, br == 3 ? 2048 : br * 512, nullptr, DestId(), scr, lane); continue; }
            r -= N_BRW;
            if (r < N_WC) {
                const int l = r / 1024, q = r % 1024, g = q / 256, part = (q / 128) & 1, cblk = (q / 32) & 3, nb = q % 32; const int n = nb * 64 + lane;
                const float* W = Pp->in[I_WBR] + ((size_t)l * 4 + 2) * 512 * 2048 + (size_t)(g * 128) * 2048 + n;
                float a[32];
#pragma unroll
                for (int c = 0; c < 32; ++c) a[c] = 0.f;
                for (int m = 0; m < 128; ++m) { const float w = W[(size_t)m * 2048];
#pragma unroll
                    for (int c = 0; c < 32; ++c) { const float rev = (float)(((cblk * 32 + c) * m) & 127) * (1.0f / 128.0f);
                        const float tv = part ? -__builtin_amdgcn_sinf(rev) : __builtin_amdgcn_cosf(rev); a[c] += tv * w; } }
                bf16_t* o = WMT + (size_t)l * 2048 * KMERGE + (size_t)n * KMERGE + 1024 + g * 256 + part * 128 + cblk * 32;
#pragma unroll
                for (int c8 = 0; c8 < 4; ++c8) { u32x4 w; const float sc = 0.08838834764831845f;
                    w.x = cvt_pk_bf16(a[c8 * 8 + 0] * sc, a[c8 * 8 + 1] * sc); w.y = cvt_pk_bf16(a[c8 * 8 + 2] * sc, a[c8 * 8 + 3] * sc);
                    w.z = cvt_pk_bf16(a[c8 * 8 + 4] * sc, a[c8 * 8 + 5] * sc); w.w = cvt_pk_bf16(a[c8 * 8 + 6] * sc, a[c8 * 8 + 7] * sc); *(u32x4*)(o + c8 * 8) = w; }
                continue; }
            r -= N_WC;
            if (r < N_WO) { const int l = r / 2048, q = r % 2048, kb = q / 64, nb = q % 64;
                transpose_item(Pp->in[I_WO] + (size_t)l * 2048 * 2048, 2048, kb * 64, nb * 32, WOT + (size_t)l * 2048 * 2048, 2048, 0, nullptr, DestId(), scr, lane); continue; }
            r -= N_WO;
            if (r < N_UQ) { const int l = r / 192, q = r % 192, kb = q / 24, nb = q % 24;
                transpose_item(Pp->in[I_DWUQ] + (size_t)l * 512 * 768, 768, kb * 64, nb * 32, WUQT + (size_t)l * 768 * 512, 512, 0, Pp->in[I_DQG] + l * 512, DestUq(), scr, lane); continue; }
            r -= N_UQ;
            if (r < N_UKV) { const int l = r / 128, q = r % 128, which = q / 64, q2 = q % 64, kb = q2 / 16, nb = q2 % 16;
                transpose_item(Pp->in[which ? I_DWUV : I_DWUK] + (size_t)l * 256 * 512, 512, kb * 64, nb * 32, WUKVT + (size_t)l * 1024 * 256, 256, 0, Pp->in[I_DKVG] + l * 256, DestOff{which * 512}, scr, lane); continue; }
            r -= N_UKV;
            if (r < 2 * N_W1) { const int which = r / N_W1, q = r % N_W1, le = q / 512, q2 = q % 512, kb = q2 / 32, nb = q2 % 32;
                transpose8_item(Pp->in[which ? I_EW3 : I_EW1] + (size_t)le * 2048 * 1024, 1024, kb * 128, nb * 32, W13T8 + (size_t)le * 2048 * 2048, 2048, DestGlu{which * 128}, scr8, lane); continue; }
            r -= 2 * N_W1;
            if (r < N_W2) { const int le = r / 512, q2 = r % 512, kb = q2 / 64, nb = q2 % 64;
                transpose8_item(Pp->in[I_EW2] + (size_t)le * 1024 * 2048, 2048, kb * 128, nb * 32, W2T8 + (size_t)le * 2048 * 1024, 1024, DestId(), scr8, lane); continue; }
            r -= N_W2;
            if (r < N_FM) {
                const int po = r >> 8, k1 = r & 255;
#pragma unroll
                for (int j = 0; j < 8; ++j) { const int col = j * 64 + lane, pi = col >> 8, n1 = col & 255; const float rev = (float)((k1 * n1) & 255) * (1.0f / 256.0f);
                    const float c = __builtin_amdgcn_cosf(rev), s = __builtin_amdgcn_sinf(rev); const float v = (po == pi) ? (po ? -c : c) : s;
                    FMAT[(size_t)r * 512 + col] = (bf16_t)f2bf(v * 0.0625f); }
                continue; }
            r -= N_FM;
            if (r < N_BIN) { const int l = r / 46, t = r % 46;
#pragma unroll
                for (int j = 0; j < 4; ++j) BINP[(size_t)l * NWIN + t * 256 + j * 64 + lane] = 0.f;
                continue; }
            r -= N_BIN;
            if (r < N_WR) {
                const int l = r / 256, kg = r % 256;
#pragma unroll
                for (int j = 0; j < 8; ++j) { const int idx = j * 64 + lane, kk = idx >> 8, col = (idx >> 2) & 63, s = idx & 3, k = kg * 8 + kk * 4 + s;
                    float v = 0.f; if (col < 4) v = Pp->in[I_RWG][((size_t)l * 2048 + k) * 4 + col]; else if (col < 36) v = Pp->in[I_RWE][((size_t)l * 2048 + k) * 32 + col - 4];
                    WR2[((size_t)l * 256 + kg) * 512 + idx] = v; }
                {
                    const int col = lane; float w8[8];
#pragma unroll
                    for (int e = 0; e < 8; ++e) { const int k = kg * 8 + e; w8[e] = col < 4 ? Pp->in[I_RWG][((size_t)l * 2048 + k) * 4 + col] : (col < 36 ? Pp->in[I_RWE][((size_t)l * 2048 + k) * 32 + col - 4] : 0.f); }
                    u32x4 hi, lo; unsigned hw[4], lw[4];
#pragma unroll
                    for (int e = 0; e < 4; ++e) { hw[e] = cvt_pk_bf16(w8[2 * e], w8[2 * e + 1]); lw[e] = cvt_pk_bf16(w8[2 * e] - bflo(hw[e]), w8[2 * e + 1] - bfhi(hw[e])); }
                    hi.x = hw[0]; hi.y = hw[1]; hi.z = hw[2]; hi.w = hw[3]; lo.x = lw[0]; lo.y = lw[1]; lo.z = lw[2]; lo.w = lw[3];
                    bf16_t* o = WSP(bf16_t, WS_H32) + (((((size_t)l * 128 + (kg >> 1)) * 2 + (col >> 5)) * 64 + (kg & 1) * 32 + (col & 31)) * 2) * 8;
                    *(u32x4*)o = hi; *(u32x4*)(o + 8) = lo; }
                continue; }
            r -= N_WR;
            { const int l = r / 224, row = 3360 + r % 224;
                u32x4* o = (u32x4*)(WINT + (size_t)l * NWIN * 2048 + (size_t)row * 2048);
#pragma unroll
                for (int j = 0; j < 4; ++j) o[j * 64 + lane] = (u32x4){0u, 0u, 0u, 0u}; }
        }
    }
    SEAM(0);
    if (SEL(12) && IN(1)) {
            PHASE_IDS;
        CP Pp = kparams(); unsigned char* ws = Pp->ws; float* MODP = WSP(float, WS_MODP); float* BINP = WSP(float, WS_BINP); bf16_t* HN = WSP(bf16_t, WS_HN); unsigned char* HN8 = WSP(unsigned char, WS_HN8);
        for (int i = bx * 512 + tid; i < 2 * DIN; i += G * 512) { const int l = i / DIN, n = i % DIN; BINP[(size_t)l * NWIN + DestWin()(n)] = Pp->in[I_BIN][i]; }
#define P1_LOAD(r, B) do { const float* xr_ = (r) < CTX ? Pp->in[I_CTX] + (size_t)(r) * D : Pp->in[I_X] + (size_t)((r) - CTX) * D; \
    _Pragma("unroll") for (int j = 0; j < 8; ++j) B[j] = *(const f32x4*)(xr_ + j * 256 + lane * 4); } while (0)
#define P1_PROC(r, B) do { const int which = (r) < CTX ? 1 : 0; const LAS float* MSw = MS + (which * 2) * 2048 + launder(lane * 4) - lane * 4; float mean, rstd; row_stats(B, mean, rstd); \
    _Pragma("unroll") for (int j = 0; j < 8; ++j) { const f32x4 sc = *(const LAS f32x4*)(MSw + j * 256 + lane * 4), sh = *(const LAS f32x4*)(MSw + 2048 + j * 256 + lane * 4); \
        const f32x4 h = (B[j] - mean) * rstd * sc + sh; u32x2 w; w.x = cvt_pk_bf16(h[0], h[1]); w.y = cvt_pk_bf16(h[2], h[3]); \
        *(u32x2*)(HN + (size_t)(r) * D + j * 256 + lane * 4) = w; \
        *(unsigned*)(HN8 + (size_t)(r) * D + j * 256 + lane * 4) = pk_fp8x4(h[0] * H8_SCALE, h[1] * H8_SCALE, h[2] * H8_SCALE, h[3] * H8_SCALE); } } while (0)
        { f32x4 b0[8], b1[8], b2[8];
          if (gw < NROW) P1_LOAD(gw, b0);
          if (gw + NGW < NROW) P1_LOAD(gw + NGW, b1);
        LAS float* MS = (LAS float*)lds;
#pragma unroll
        for (int which = 0; which < 2; ++which) { mod_vec(MS + (which * 2 + 0) * 2048, MODP, Pp->in[I_BADA], 0, which, 1, 1.f, tid); mod_vec(MS + (which * 2 + 1) * 2048, MODP, Pp->in[I_BADA], 0, which, 0, 0.f, tid); }
        for (int idx = bx * 512 + tid; idx < 12288; idx += G * 512) { const int k = (idx & 511) * 4, t = idx >> 9, j = t % 6, which = (t / 6) & 1, l2 = t / 12;
            f32x4 s = *(const f32x4*)(Pp->in[I_BADA] + (size_t)l2 * 12288 + j * 2048 + k);
#pragma unroll
            for (int sl = 0; sl < NSLAB; ++sl) s += *(const f32x4*)(MODP + (((size_t)l2 * NSLAB + sl) * 2 + which) * 12288 + j * 2048 + k);
            *(f32x4*)(WSP(float, WS_H32 + (2u << 20)) + (size_t)((l2 * 2 + which) * 6 + j) * 2048 + k) = s; }
          if (gw + 2 * NGW < NROW) P1_LOAD(gw + 2 * NGW, b2);
        __syncthreads();
          for (int row = gw; row < NROW; row += 3 * NGW) {
              P1_PROC(row, b0); if (row + 3 * NGW < NROW) P1_LOAD(row + 3 * NGW, b0);
              if (row + NGW < NROW) { P1_PROC(row + NGW, b1); if (row + 4 * NGW < NROW) P1_LOAD(row + 4 * NGW, b1); }
              if (row + 2 * NGW < NROW) { P1_PROC(row + 2 * NGW, b2); if (row + 5 * NGW < NROW) P1_LOAD(row + 5 * NGW, b2); } } }
    }
    SEAM(1);

    layer_phases<0>(lo, hi, bar, lds);
    layer_phases<1>(lo, hi, bar, lds);
#undef IN
#undef SEAM
}

extern "C" void kernel_launch(void* const* d_in, const int* in_sizes, int n_in, void* d_out, int out_size, void* d_ws, size_t ws_size, hipStream_t stream) {
    static int grid = 0;
    if (grid == 0) {
        if (n_in != 34 || out_size != SEQ * D || ws_size < WS_END) { fprintf(stderr, "kernel_launch: unexpected shapes: n_in %d out %d ws %zu (need %zu)\n", n_in, out_size, ws_size, (size_t)WS_END); grid = -1; return; }
        if (hipFuncSetAttribute((const void*)fwd_kernel, hipFuncAttributeMaxDynamicSharedMemorySize, LDS_BYTES) != hipSuccess) { fprintf(stderr, "kernel_launch: hipFuncSetAttribute failed\n"); grid = -1; return; }
        int per_cu = 0;
        if (hipOccupancyMaxActiveBlocksPerMultiprocessor(&per_cu, (const void*)fwd_kernel, 512, LDS_BYTES) != hipSuccess || per_cu < 1) fprintf(stderr, "kernel_launch: occupancy query reports %d\n", per_cu);
        (void)hipGetLastError();
        grid = 256;
    }
    if (grid < 0) return;
    (void)hipMemsetAsync((char*)d_ws + WS_CTL + (size_t)CW_BAR * 4, 0, (size_t)XCD_BAR_WORDS * 4, stream);
    Params p{};
    for (int i = 0; i < 34; ++i) p.in[i] = (const float*)d_in[i];
    p.out = (float*)d_out; p.ws = (unsigned char*)d_ws;
#if MK_LAUNCH_PER_PHASE
    for (int k = 0; k < NPHASE; ++k) { p.ph_lo = k; p.ph_hi = k + 1; hipLaunchKernelGGL(fwd_kernel, dim3(grid), dim3(512), LDS_BYTES, stream, p); }
#else
    p.ph_lo = 0; p.ph_hi = NPHASE;
    hipLaunchKernelGGL(fwd_kernel, dim3(grid), dim3(512), LDS_BYTES, stream, p);
#endif
    const hipError_t le = hipPeekAtLastError();
    if (le != hipSuccess) fprintf(stderr, "kernel_launch: launch failed: %s\n", hipGetErrorName(le));
}
```
